# Optimizing an MI355X kernel written in HIP

```python
import math
import jax
import jax.numpy as jnp
from jax import lax
import numpy as np

D_MODEL = 1024
BATCH = 4
SEQ = 8192
DEPTH = 2

HEAD_DIM = 64
BRANCH_WIDTH = D_MODEL // 2
N_BRANCH = 3
CONV_WIDTH = BRANCH_WIDTH
CONV_K = 3
FOX_HEADS = BRANCH_WIDTH // HEAD_DIM
SWA_HEADS = BRANCH_WIDTH // HEAD_DIM
SWA_KV_HEADS = 2
SWA_GROUP = SWA_HEADS // SWA_KV_HEADS
WINDOW = 128
BLOCK = 128
N_BUCKETS = 32
MAX_DISTANCE = WINDOW
MEM_LEN = 256
X_HEADS = 4
X_HEAD_DIM = D_MODEL // X_HEADS
_FF_RAW = -(-8 * D_MODEL // 3)
D_FF = -(-_FF_RAW // 256) * 256
IN_COLS = (3 * CONV_WIDTH + 3 * FOX_HEADS * HEAD_DIM + FOX_HEADS
           + (SWA_HEADS + 2 * SWA_KV_HEADS) * HEAD_DIM + N_BRANCH * D_MODEL)
RMS_EPS = 1e-6
NEG_INF = -1e30

kernel_name = "hybrid_conv_fox_swa_block"


def rms_norm(x, g):
    xf = x.astype(jnp.float32)
    y = xf * lax.rsqrt(jnp.mean(xf * xf, axis=-1, keepdims=True) + RMS_EPS)
    return (y * g.astype(jnp.float32)).astype(x.dtype)


def split_proj(proj):
    sizes = ([CONV_WIDTH] * 3 + [FOX_HEADS * HEAD_DIM] * 3 + [FOX_HEADS]
             + [SWA_HEADS * HEAD_DIM, SWA_KV_HEADS * HEAD_DIM, SWA_KV_HEADS * HEAD_DIM]
             + [N_BRANCH * D_MODEL])
    parts, off = [], 0
    for s in sizes:
        parts.append(proj[..., off:off + s])
        off += s
    return parts


def short_conv_branch(gate_b, gate_c, u, conv_w):
    z = gate_c * u
    y = lax.conv_general_dilated(
        z, conv_w[:, None, :].astype(z.dtype), window_strides=(1,),
        padding=[(CONV_K - 1, 0)], dimension_numbers=('NWC', 'WIO', 'NWC'),
        feature_group_count=CONV_WIDTH)
    return gate_b * y


def fox_branch(q, k, v, f_logit, f_bias):
    b, s = q.shape[0], q.shape[1]
    nb = s // BLOCK
    q = q.reshape(b, s, FOX_HEADS, HEAD_DIM)
    k = k.reshape(b, s, FOX_HEADS, HEAD_DIM)
    v = v.reshape(b, s, FOX_HEADS, HEAD_DIM)
    log_f = jax.nn.log_sigmoid(f_logit.astype(jnp.float32) + f_bias.astype(jnp.float32))
    c = jnp.cumsum(log_f, axis=1)
    c_k = c.transpose(0, 2, 1)
    q_blocks = q.reshape(b, nb, BLOCK, FOX_HEADS, HEAD_DIM).transpose(1, 0, 2, 3, 4)
    c_blocks = c.reshape(b, nb, BLOCK, FOX_HEADS).transpose(1, 0, 2, 3)
    starts = jnp.arange(nb, dtype=jnp.int32) * BLOCK
    k_pos = jnp.arange(s, dtype=jnp.int32)
    scale = HEAD_DIM ** -0.5

    def one_block(args):
        qi, ci, start = args
        logits = jnp.einsum('bqhd,bkhd->bhqk', qi, k).astype(jnp.float32) * scale
        logits = logits + ci.transpose(0, 2, 1)[..., None] - c_k[:, :, None, :]
        q_pos = start + jnp.arange(BLOCK, dtype=jnp.int32)
        causal = k_pos[None, :] <= q_pos[:, None]
        logits = jnp.where(causal[None, None], logits, NEG_INF)
        p = jax.nn.softmax(logits, axis=-1)
        return jnp.einsum('bhqk,bkhd->bqhd', p.astype(v.dtype), v)

    out = lax.map(one_block, (q_blocks, c_blocks, starts))
    return out.transpose(1, 0, 2, 3, 4).reshape(b, s, FOX_HEADS * HEAD_DIM)


def t5_bucket(n):
    n = jnp.maximum(n, 0)
    max_exact = N_BUCKETS // 2
    large = max_exact + (
        jnp.log(jnp.maximum(n, 1).astype(jnp.float32) / max_exact)
        / math.log(MAX_DISTANCE / max_exact) * (N_BUCKETS - max_exact)).astype(jnp.int32)
    large = jnp.minimum(large, N_BUCKETS - 1)
    return jnp.where(n < max_exact, n, large)


def swa_sink_branch(q, k, v, rel_bias, sink):
    b, s = q.shape[0], q.shape[1]
    nb = s // BLOCK
    qb = q.reshape(b, nb, BLOCK, SWA_KV_HEADS, SWA_GROUP, HEAD_DIM)
    kb = k.reshape(b, nb, BLOCK, SWA_KV_HEADS, HEAD_DIM)
    vb = v.reshape(b, nb, BLOCK, SWA_KV_HEADS, HEAD_DIM)

    def band(t):
        prev = jnp.concatenate([jnp.zeros_like(t[:, :1]), t[:, :-1]], axis=1)
        return jnp.concatenate([prev, t], axis=2)

    k_band, v_band = band(kb), band(vb)
    tq = jnp.arange(BLOCK, dtype=jnp.int32)
    sk = jnp.arange(2 * BLOCK, dtype=jnp.int32)
    dist = BLOCK + tq[:, None] - sk[None, :]
    in_window = (dist >= 0) & (dist < WINDOW)
    key_pos = jnp.arange(nb, dtype=jnp.int32)[:, None] * BLOCK - BLOCK + sk[None, :]
    mask = in_window[None] & (key_pos >= 0)[:, None, :]
    bias = rel_bias.astype(jnp.float32)[t5_bucket(dist)]
    bias = bias.reshape(BLOCK, 2 * BLOCK, SWA_KV_HEADS, SWA_GROUP).transpose(2, 3, 0, 1)
    logits = jnp.einsum('bnqkgd,bnskd->bnkgqs', qb, k_band).astype(jnp.float32) * HEAD_DIM ** -0.5
    logits = jnp.where(mask[None, :, None, None], logits + bias, NEG_INF)
    sink_l = sink.astype(jnp.float32).reshape(SWA_KV_HEADS, SWA_GROUP)[None, None, :, :, None]
    m = jnp.maximum(logits.max(axis=-1), sink_l)
    p = jnp.exp(logits - m[..., None])
    denom = p.sum(axis=-1) + jnp.exp(sink_l - m)
    p = p / denom[..., None]
    out = jnp.einsum('bnkgqs,bnskd->bnqkgd', p.astype(v.dtype), v_band)
    return out.reshape(b, s, SWA_HEADS * HEAD_DIM)


def cross_attention(xn, mem_n, w_q, w_kv, w_o):
    b, s = xn.shape[0], xn.shape[1]
    q = (xn @ w_q).reshape(b, s, X_HEADS, X_HEAD_DIM)
    kv = mem_n @ w_kv
    k = kv[..., :X_HEADS * X_HEAD_DIM].reshape(b, -1, X_HEADS, X_HEAD_DIM)
    v = kv[..., X_HEADS * X_HEAD_DIM:].reshape(b, -1, X_HEADS, X_HEAD_DIM)
    logits = jnp.einsum('bshd,bmhd->bhsm', q, k).astype(jnp.float32) * X_HEAD_DIM ** -0.5
    p = jax.nn.softmax(logits, axis=-1)
    o = jnp.einsum('bhsm,bmhd->bshd', p.astype(v.dtype), v).reshape(b, s, X_HEADS * X_HEAD_DIM)
    return o @ w_o


def swiglu(xn, w_gate, w_up, w_down):
    return (jax.nn.silu(xn @ w_gate) * (xn @ w_up)) @ w_down


def setup_inputs(seed: int = 0) -> dict:
    key = jax.random.key(seed)
    ks = jax.random.split(key, 22)
    f32 = jnp.float32

    def nrm(k, shape, scale):
        return scale * jax.random.normal(k, shape, f32)

    def gain(k, shape):
        return 1.0 + 0.1 * jax.random.normal(k, shape, f32)

    return {
        "x": nrm(ks[0], (BATCH, SEQ, D_MODEL), 1.0),
        "mem": nrm(ks[1], (BATCH, MEM_LEN, D_MODEL), 1.0),
        "mix_norm_g": gain(ks[2], (DEPTH, D_MODEL)),
        "w_in": nrm(ks[3], (DEPTH, D_MODEL, IN_COLS), D_MODEL ** -0.5),
        "forget_bias": 4.0 + 0.5 * jax.random.normal(ks[4], (DEPTH, FOX_HEADS), f32),
        "conv_w": nrm(ks[5], (DEPTH, CONV_K, CONV_WIDTH), CONV_K ** -0.5),
        "sink": nrm(ks[6], (DEPTH, SWA_HEADS), 0.5),
        "w_branch": nrm(ks[7], (DEPTH, N_BRANCH, BRANCH_WIDTH, D_MODEL), BRANCH_WIDTH ** -0.5),
        "w_mix_out": nrm(ks[8], (DEPTH, D_MODEL, D_MODEL), D_MODEL ** -0.5),
        "rel_bias": nrm(ks[9], (N_BUCKETS, SWA_HEADS), 0.5),
        "xattn_norm_g": gain(ks[10], (DEPTH, D_MODEL)),
        "mem_norm_g": gain(ks[11], (DEPTH, D_MODEL)),
        "w_xq": nrm(ks[12], (DEPTH, D_MODEL, X_HEADS * X_HEAD_DIM), D_MODEL ** -0.5),
        "w_xkv": nrm(ks[13], (DEPTH, D_MODEL, 2 * X_HEADS * X_HEAD_DIM), D_MODEL ** -0.5),
        "w_xo": nrm(ks[14], (DEPTH, X_HEADS * X_HEAD_DIM, D_MODEL), (X_HEADS * X_HEAD_DIM) ** -0.5),
        "ffn_norm_g": gain(ks[15], (DEPTH, D_MODEL)),
        "w_ffn_gate": nrm(ks[16], (DEPTH, D_MODEL, D_FF), D_MODEL ** -0.5),
        "w_ffn_up": nrm(ks[17], (DEPTH, D_MODEL, D_FF), D_MODEL ** -0.5),
        "w_ffn_down": nrm(ks[18], (DEPTH, D_FF, D_MODEL), D_FF ** -0.5),
        "final_norm_g": gain(ks[19], (D_MODEL,)),
    }


def reference(x, mem, mix_norm_g, w_in, forget_bias, conv_w, sink, w_branch, w_mix_out,
              rel_bias, xattn_norm_g, mem_norm_g, w_xq, w_xkv, w_xo, ffn_norm_g,
              w_ffn_gate, w_ffn_up, w_ffn_down, final_norm_g):
    b, s = x.shape[0], x.shape[1]
    for l in range(DEPTH):
        h = rms_norm(x, mix_norm_g[l])
        (c_b, c_c, c_u, f_q, f_k, f_v, f_g, s_q, s_k, s_v, gate_logits) = split_proj(h @ w_in[l])
        y_conv = short_conv_branch(c_b, c_c, c_u, conv_w[l])
        y_fox = fox_branch(f_q, f_k, f_v, f_g, forget_bias[l])
        y_swa = swa_sink_branch(s_q, s_k, s_v, rel_bias, sink[l])
        gates = jax.nn.sigmoid(gate_logits.reshape(b, s, N_BRANCH, D_MODEL))
        merged = (gates[:, :, 0] * (y_conv @ w_branch[l, 0])
                  + gates[:, :, 1] * (y_fox @ w_branch[l, 1])
                  + gates[:, :, 2] * (y_swa @ w_branch[l, 2]))
        x = x + merged @ w_mix_out[l]
        x = x + cross_attention(rms_norm(x, xattn_norm_g[l]), rms_norm(mem, mem_norm_g[l]),
                                w_xq[l], w_xkv[l], w_xo[l])
        x = x + swiglu(rms_norm(x, ffn_norm_g[l]), w_ffn_gate[l], w_ffn_up[l], w_ffn_down[l])
    return rms_norm(x, final_norm_g)
```

```cpp
#include <hip/hip_runtime.h>
#include <hip/hip_cooperative_groups.h>
#include <cstdio>
#include <cstdint>
#include <hip/hip_bf16.h>
#include <cmath>
namespace cg = cooperative_groups;

#ifndef MK_DUP_LO
#define MK_DUP_LO -1
#define MK_DUP_HI -1
#define MK_DUPN 0
#endif
#ifndef MK_SINGLE
#define MK_SINGLE 1
#endif

#define LAS __attribute__((address_space(3)))
typedef unsigned short bf16_t;
typedef short bf16x8 __attribute__((ext_vector_type(8)));
typedef float f32x4 __attribute__((ext_vector_type(4)));
typedef unsigned u32x4 __attribute__((ext_vector_type(4)));
typedef unsigned u32x2 __attribute__((ext_vector_type(2)));
typedef short v4i16_t __attribute__((ext_vector_type(4)));

constexpr int DM = 1024, NB = 4, SEQ = 8192, TOK = NB * SEQ, DEPTH = 2;
constexpr int PROJ_LD = 6912, W1_ROWS = 7168, IN_COLS = 6920, DFF = 2816, MEMLEN = 256;
constexpr float LOG2E = 1.4426950408889634f;
constexpr float C2_64 = 0.125f * LOG2E;
constexpr float C2_256 = 0.0625f * LOG2E;
constexpr float RMS_EPS = 1e-6f;
constexpr int PC_B = 0, PC_C = 512, PC_U = 1024, PC_FQ = 1536, PC_FK = 2048, PC_FV = 2560, PC_SQ = 3072, PC_SK = 3584, PC_SV = 3712, PC_G = 3840;

constexpr size_t MiB = 1u << 20;
constexpr size_t WS_PART = 1 * MiB, WS_PARTM = 3 * MiB, WS_LOGF = 4 * MiB, WS_KX = 5 * MiB, WS_XB = 12 * MiB, WS_BIG = 76 * MiB;
constexpr size_t DO_W = 0, W_LAYER = 40 * MiB, DO_WKVT = 80 * MiB, DO_KVM = 88 * MiB, DO_MEMB = 96 * MiB;
constexpr size_t WO_W1T = 0, WO_WBT = 14 * MiB, WO_WOT = 17 * MiB, WO_WXQT = 19 * MiB, WO_WXOT = 21 * MiB, WO_WGUT = 23 * MiB, WO_WDT = 34 * MiB;
constexpr size_t BIG_MIN = (size_t)TOK * (DM + DFF) * 2;
constexpr size_t WS_MERGED2 = WS_BIG + BIG_MIN;
constexpr size_t WS_NEED2 = WS_MERGED2 + (size_t)TOK * DM * 2, WS_NEED1 = WS_BIG + (size_t)TOK * PROJ_LD * 2;

constexpr int LDS_BYTES = 147456;

__device__ __forceinline__ unsigned cvt_pk_bf16(float lo, float hi) { unsigned r; asm("v_cvt_pk_bf16_f32 %0, %1, %2" : "=v"(r) : "v"(lo), "v"(hi)); return r; }
__device__ __forceinline__ float bf_lo(unsigned w) { return __uint_as_float(w << 16); }
__device__ __forceinline__ float bf_hi(unsigned w) { return __uint_as_float(w & 0xffff0000u); }
__device__ __forceinline__ float fast_sigmoid(float v) { return __builtin_amdgcn_rcpf(1.0f + __builtin_amdgcn_exp2f(-v * LOG2E)); }

namespace pg8 {
constexpr int BM = 256, BK = 64, HALF = 128, HTB = HALF * BK * 2, STAGE_BYTES = 8 * HTB, NXCD = 8, WGM = 8;
__host__ __device__ __forceinline__ int lds_byte(int r, int c) { const int st = (r >> 4) * 2 + (c >> 5), rr = r & 15, cc = c & 31, ob = rr * 64 + cc * 2; return st * 1024 + (ob ^ (((ob >> 9) & 1) << 5)); }
__host__ __device__ __forceinline__ void stage_rc(int b, int& R, int& C) { const int st = b / 1024, sb = b % 1024, swz = sb ^ (((sb >> 9) & 1) << 5); R = (st >> 1) * 16 + swz / 64; C = (st & 1) * 32 + (swz % 64) / 2; }
__host__ __device__ __forceinline__ int perm32(int rho) { const int n = rho >> 4, i = rho & 15; return 8 * (i >> 2) + 4 * n + (i & 3); }

struct Unit { int pm, pn, seg, idx; };
struct Gemm { const bf16_t* A; const bf16_t* Bt; int lda, ldb, K, sas, sbs;
    __device__ __forceinline__ int sa(int s) const { return s * sas; } __device__ __forceinline__ int sb(int s) const { return s * sbs; } };

template <int NSEG> struct StaticOrder {
    int nM, nN, nwg, G, c;
    __device__ void init(int M, int N, int G_, int c_) { nM = M / BM; nN = N / BM; nwg = nM * nN; G = G_; c = c_; }
    __device__ bool next(int i, Unit& u) const {
        const int ui = i / NSEG; u.seg = i - ui * NSEG; u.idx = ui;
        const long L = (long)ui * G + c; if (L >= nwg) return false;
        int wgid = (int)L; { const int q = nwg / NXCD, r = nwg % NXCD, xcd = wgid % NXCD, off = wgid / NXCD; wgid = (xcd < r ? xcd * (q + 1) : r * (q + 1) + (xcd - r) * q) + off; }
        const int nig = WGM * nN, gid = wgid / nig, fm = gid * WGM, gsz = (nM - fm) < WGM ? (nM - fm) : WGM;
        u.pm = fm + ((wgid % nig) % gsz); u.pn = (wgid % nig) / gsz; return true;
    }
};

template <class Epi, int NSEG>
__device__ __forceinline__ void gemm_phase(LAS unsigned char* lds, const Gemm g, const StaticOrder<NSEG>& S, const Epi& E) {
    int tid_ = threadIdx.x; asm volatile("" : "+v"(tid_));
    const int tid = tid_, wid = __builtin_amdgcn_readfirstlane(tid >> 6), lane = tid & 63, wr = wid >> 2, wc = wid & 3, fr = lane & 15, fq = lane >> 4;
    const int K = g.K, nt = K / BK;
    unsigned voffA[2], voffB[2];
#pragma unroll
    for (int i = 0; i < 2; ++i) { int R, C; stage_rc(tid * 16 + i * 8192, R, C); const int Rb = (R & ~31) + perm32(R & 31);
        voffA[i] = (unsigned)(R * g.lda + C) * 2u; voffB[i] = (unsigned)(Rb * g.ldb + C) * 2u; }
    const size_t kstep = (size_t)(BK * 2);
    const size_t hstepA = (size_t)HALF * g.lda * 2, hstepB = (size_t)HALF * g.ldb * 2;
    const size_t tstepA = 2 * hstepA, tstepB = 2 * hstepB;
    const unsigned ldsw = (unsigned)wid * 1024u;
    const int aoff = lds_byte(wr * 64 + fr, fq * 8), boff = lds_byte(wc * 32 + fr, fq * 8);
#define PG8_SA(b, h) (((b) * 2 + (h)) * HTB)
#define PG8_SB(b, h) ((4 + (b) * 2 + (h)) * HTB)
#define PG8_STAGE(bufoff, gbase, voff) do { _Pragma("unroll") for (int _i = 0; _i < 2; ++_i) \
        __builtin_amdgcn_global_load_lds((const unsigned*)((const char*)(gbase) + (voff)[_i]), (LAS unsigned*)(lds + (bufoff) + ldsw + _i * 8192), 16, 0, 0); } while (0)
#define PG8_LDA(dst, b, h) do { _Pragma("unroll") for (int m = 0; m < 4; ++m) _Pragma("unroll") for (int k = 0; k < 2; ++k) dst[m][k] = *(const LAS bf16x8*)(lds + PG8_SA(b, h) + aoff + m * 2048 + k * 1024); } while (0)
#define PG8_LDB(dst, b, h) do { _Pragma("unroll") for (int n = 0; n < 2; ++n) _Pragma("unroll") for (int k = 0; k < 2; ++k) dst[n][k] = *(const LAS bf16x8*)(lds + PG8_SB(b, h) + boff + n * 2048 + k * 1024); } while (0)
#define PG8_MMA(ai, bj, At, Bt) do { __builtin_amdgcn_s_setprio(1); _Pragma("unroll") for (int m = 0; m < 4; ++m) _Pragma("unroll") for (int n = 0; n < 2; ++n) _Pragma("unroll") for (int k = 0; k < 2; ++k) \
        acc[ai][bj][m][n] = __builtin_amdgcn_mfma_f32_16x16x32_bf16(Bt[n][k], At[m][k], acc[ai][bj][m][n], 0, 0, 0); __builtin_amdgcn_s_setprio(0); } while (0)
#define PG8_WAIT_V(n) asm volatile("s_waitcnt vmcnt(" #n ")" ::: "memory")
#define PG8_WAIT_L(n) asm volatile("s_waitcnt lgkmcnt(" #n ")" ::: "memory")
#define PG8_BAR __builtin_amdgcn_s_barrier()
#define PG8_SCHED __builtin_amdgcn_sched_barrier(0)
    Unit cur, nxt; int ui = 0;
    if (!S.next(0, cur)) return;
    f32x4 acc[2][2][4][2];
#pragma unroll
    for (int a = 0; a < 2; ++a)
#pragma unroll
        for (int b = 0; b < 2; ++b)
#pragma unroll
            for (int m = 0; m < 4; ++m)
#pragma unroll
                for (int n = 0; n < 2; ++n) acc[a][b][m][n] = (f32x4){0.f, 0.f, 0.f, 0.f};
    bf16x8 At[4][2], B0[2][2], B1[2][2];
    const char* cA = (const char*)g.A + (size_t)cur.pm * tstepA + (size_t)g.sa(cur.seg) * 2; const char* cB = (const char*)g.Bt + (size_t)cur.pn * tstepB + (size_t)g.sb(cur.seg) * 2;
    PG8_STAGE(PG8_SB(0, 0), cB, voffB); PG8_STAGE(PG8_SB(0, 1), cB + hstepB, voffB); PG8_STAGE(PG8_SA(0, 0), cA, voffA); PG8_STAGE(PG8_SA(0, 1), cA + hstepA, voffA);
    if (wr == 1) PG8_BAR;
    PG8_WAIT_V(2); PG8_BAR;
    PG8_STAGE(PG8_SB(1, 0), cB + kstep, voffB); PG8_STAGE(PG8_SA(1, 0), cA + kstep, voffA); PG8_STAGE(PG8_SB(1, 1), cB + hstepB + kstep, voffB);
    PG8_WAIT_V(6); PG8_BAR;
    for (;;) {
        const bool has_next = S.next(ui + 1, nxt);
        const char* nA = has_next ? (const char*)g.A + (size_t)nxt.pm * tstepA + (size_t)g.sa(nxt.seg) * 2 : cA;
        const char* nB = has_next ? (const char*)g.Bt + (size_t)nxt.pn * tstepB + (size_t)g.sb(nxt.seg) * 2 : cB;
        for (int t = 0; t < nt; t += 2) {
            const bool last = (t == nt - 2);
            const char* a1 = cA + (size_t)(t + 1) * kstep;
            const char* a2 = last ? nA : cA + (size_t)(t + 2) * kstep; const char* b2 = last ? nB : cB + (size_t)(t + 2) * kstep;
            const char* a3 = a2 + kstep; const char* b3 = b2 + kstep;
            PG8_LDB(B0, 0, 0); PG8_LDB(B1, 0, 1); PG8_SCHED; PG8_LDA(At, 0, 0); PG8_STAGE(PG8_SA(1, 1), a1 + hstepA, voffA);
            PG8_WAIT_V(8); PG8_WAIT_L(0); PG8_BAR; PG8_MMA(0, 0, At, B0); PG8_MMA(0, 1, At, B1); PG8_BAR; PG8_SCHED;
            PG8_LDA(At, 0, 1); PG8_STAGE(PG8_SB(0, 0), b2, voffB); PG8_STAGE(PG8_SB(0, 1), b2 + hstepB, voffB); PG8_STAGE(PG8_SA(0, 0), a2, voffA);
            PG8_WAIT_V(8); PG8_WAIT_L(0); PG8_BAR; PG8_MMA(1, 0, At, B0); PG8_MMA(1, 1, At, B1); PG8_BAR; PG8_SCHED;
            PG8_LDB(B0, 1, 0); PG8_LDB(B1, 1, 1); PG8_SCHED; PG8_LDA(At, 1, 0); PG8_STAGE(PG8_SA(0, 1), a2 + hstepA, voffA);
            PG8_WAIT_V(8); PG8_WAIT_L(0); PG8_BAR; PG8_MMA(0, 0, At, B0); PG8_MMA(0, 1, At, B1); PG8_BAR; PG8_SCHED;
            PG8_LDA(At, 1, 1); PG8_STAGE(PG8_SB(1, 0), b3, voffB); PG8_STAGE(PG8_SB(1, 1), b3 + hstepB, voffB); PG8_STAGE(PG8_SA(1, 0), a3, voffA);
            PG8_WAIT_V(8); PG8_WAIT_L(0); PG8_BAR; PG8_MMA(1, 0, At, B0); PG8_MMA(1, 1, At, B1); PG8_BAR; PG8_SCHED;
        }
        if (wr == 0) PG8_BAR;
        E(acc, cur, wr, wc, fr, fq);
        if (!has_next) break;
        if (NSEG == 1 || cur.seg == NSEG - 1) {
#pragma unroll
            for (int a = 0; a < 2; ++a)
#pragma unroll
                for (int b = 0; b < 2; ++b)
#pragma unroll
                    for (int m = 0; m < 4; ++m)
#pragma unroll
                        for (int n = 0; n < 2; ++n) acc[a][b][m][n] = (f32x4){0.f, 0.f, 0.f, 0.f};
        }
        cur = nxt; cA = nA; cB = nB; ++ui;
        if (wr == 1) PG8_BAR;
    }
    PG8_WAIT_V(0);
    PG8_BAR;
#undef PG8_SA
#undef PG8_SB
#undef PG8_STAGE
#undef PG8_LDA
#undef PG8_LDB
#undef PG8_MMA
#undef PG8_WAIT_V
#undef PG8_WAIT_L
#undef PG8_BAR
#undef PG8_SCHED
}
}

typedef f32x4 Acc[2][2][4][2];

constexpr int RSTD_TAB_OFF = 131072, RSTD_TAB_UNITS = 15;
template <class Sched> __device__ __forceinline__ void prep_rstd(LAS unsigned char* lds, const float* part, const Sched& S) {
    LAS float* tab = (LAS float*)(lds + RSTD_TAB_OFF); pg8::Unit u;
    int t_ = threadIdx.x; asm volatile("" : "+v"(t_));
    const int r = t_ & 255;
    for (int i = t_ >> 8; i < RSTD_TAB_UNITS && S.next(i, u); i += 2) {
        const f32x4* p = (const f32x4*)(part + (size_t)(u.pm * 256 + r) * 16);
        const f32x4 a = p[0], b = p[1], c = p[2], d = p[3];
        const float sm = ((a[0] + a[1]) + (a[2] + a[3])) + ((b[0] + b[1]) + (b[2] + b[3])) + ((c[0] + c[1]) + (c[2] + c[3])) + ((d[0] + d[1]) + (d[2] + d[3]));
        tab[i * 256 + r] = 1.0f / sqrtf(sm * (1.0f / DM) + RMS_EPS);
    }
    __syncthreads();
}
__device__ __forceinline__ void row_rstd(const LAS float* tab, const pg8::Unit& u, int wr, int fr, float (&rs)[2][4]) {
#pragma unroll
    for (int ai = 0; ai < 2; ++ai)
#pragma unroll
        for (int m = 0; m < 4; ++m) rs[ai][m] = tab[u.idx * 256 + ai * 128 + wr * 64 + m * 16 + fr];
}
__device__ __forceinline__ u32x4 pack8(const f32x4 a, const f32x4 b) { u32x4 w; w.x = cvt_pk_bf16(a[0], a[1]); w.y = cvt_pk_bf16(a[2], a[3]); w.z = cvt_pk_bf16(b[0], b[1]); w.w = cvt_pk_bf16(b[2], b[3]); return w; }

struct EpiInProj {
    bf16_t* proj; float* logf; const LAS float* tab; const float* fbias;
    __device__ __forceinline__ void operator()(Acc& acc, const pg8::Unit& u, int wr, int wc, int fr, int fq) const {
        const int row0 = u.pm * 256 + wr * 64 + fr;
        float rs[2][4]; row_rstd(tab, u, wr, fr, rs);
        if (u.pn == 27) {
            if (wc == 0 && fq == 0) {
                const f32x4 b0 = *(const f32x4*)(fbias), b1 = *(const f32x4*)(fbias + 4);
#pragma unroll
                for (int ai = 0; ai < 2; ++ai)
#pragma unroll
                    for (int m = 0; m < 4; ++m) {
                        f32x4 v0 = acc[ai][0][m][0] * rs[ai][m] + b0, v1 = acc[ai][0][m][1] * rs[ai][m] + b1;
#pragma unroll
                        for (int j = 0; j < 4; ++j) { v0[j] = v0[j] >= 0.f ? -log1pf(expf(-v0[j])) : v0[j] - log1pf(expf(v0[j])); v1[j] = v1[j] >= 0.f ? -log1pf(expf(-v1[j])) : v1[j] - log1pf(expf(v1[j])); }
                        float* o = logf + (size_t)(row0 + ai * 128 + m * 16) * 8;
                        *(f32x4*)o = v0; *(f32x4*)(o + 4) = v1;
                    }
            }
            return;
        }
        const bool sig = u.pn >= 15;
        const float sc = (u.pn == 6 || u.pn == 7 || u.pn == 12 || u.pn == 13) ? C2_64 : 1.0f;
        const int col0 = u.pn * 256 + wc * 32 + 8 * fq;
#pragma unroll
        for (int ai = 0; ai < 2; ++ai)
#pragma unroll
            for (int m = 0; m < 4; ++m) {
                const float r = rs[ai][m] * sc;
                bf16_t* rowp = proj + (size_t)(row0 + ai * 128 + m * 16) * PROJ_LD + col0;
#pragma unroll
                for (int bj = 0; bj < 2; ++bj) {
                    f32x4 v0 = acc[ai][bj][m][0] * r, v1 = acc[ai][bj][m][1] * r;
                    if (sig) {
#pragma unroll
                        for (int j = 0; j < 4; ++j) { v0[j] = fmaxf(fast_sigmoid(v0[j]), 1e-6f); v1[j] = fmaxf(fast_sigmoid(v1[j]), 1e-6f); }
                    }
                    *(u32x4*)(rowp + bj * 128) = pack8(v0, v1);
                }
            }
    }
};
struct EpiMerge {
    const bf16_t* proj; bf16_t* merged; int ldm;
    __device__ __forceinline__ void operator()(Acc& acc, const pg8::Unit& u, int wr, int wc, int fr, int fq) const {
        const int row0 = u.pm * 256 + wr * 64 + fr, col0 = u.pn * 256 + wc * 32 + 8 * fq;
#pragma unroll
        for (int ai = 0; ai < 2; ++ai) {
            const bf16_t* gp0 = proj + (size_t)(row0 + ai * 128) * PROJ_LD + PC_G + 1024 * u.seg + col0;
            if (u.seg < 2) {
#pragma unroll
                for (int m = 0; m < 4; ++m) {
                    const bf16_t* gp = gp0 + (size_t)m * 16 * PROJ_LD;
#pragma unroll
                    for (int bj = 0; bj < 2; ++bj) {
                        const u32x4 ga = *(const u32x4*)(gp + bj * 128), gb = *(const u32x4*)(gp + 1024 + bj * 128);
                        f32x4 f0 = {bf_lo(ga.x), bf_hi(ga.x), bf_lo(ga.y), bf_hi(ga.y)}, f1 = {bf_lo(ga.z), bf_hi(ga.z), bf_lo(ga.w), bf_hi(ga.w)};
                        const f32x4 h0 = {bf_lo(gb.x), bf_hi(gb.x), bf_lo(gb.y), bf_hi(gb.y)}, h1 = {bf_lo(gb.z), bf_hi(gb.z), bf_lo(gb.w), bf_hi(gb.w)};
#pragma unroll
                        for (int j = 0; j < 4; ++j) { f0[j] *= __builtin_amdgcn_rcpf(h0[j]); f1[j] *= __builtin_amdgcn_rcpf(h1[j]); }
                        acc[ai][bj][m][0] *= f0; acc[ai][bj][m][1] *= f1;
                    }
                }
            } else {
                u32x4 g[4][2];
#pragma unroll
                for (int m = 0; m < 4; ++m)
#pragma unroll
                    for (int bj = 0; bj < 2; ++bj) g[m][bj] = *(const u32x4*)(gp0 + (size_t)m * 16 * PROJ_LD + bj * 128);
#pragma unroll
                for (int m = 0; m < 4; ++m)
#pragma unroll
                    for (int bj = 0; bj < 2; ++bj) { const u32x4 ga = g[m][bj];
                        const f32x4 f0 = {bf_lo(ga.x), bf_hi(ga.x), bf_lo(ga.y), bf_hi(ga.y)}, f1 = {bf_lo(ga.z), bf_hi(ga.z), bf_lo(ga.w), bf_hi(ga.w)};
                        *(u32x4*)(merged + (size_t)(row0 + ai * 128 + m * 16) * ldm + col0 + bj * 128) = pack8(acc[ai][bj][m][0] * f0, acc[ai][bj][m][1] * f1); }
            }
        }
    }
};
struct EpiResid {
    const float* basef; bf16_t* xb; float* part;
    __device__ __forceinline__ void operator()(Acc& acc, const pg8::Unit& u, int wr, int wc, int fr, int fq) const {
        const int row0 = u.pm * 256 + wr * 64 + fr, col0 = u.pn * 256 + wc * 32 + 8 * fq;
#pragma unroll
        for (int ai = 0; ai < 2; ++ai) {
            if (basef) {
#pragma unroll
                for (int m = 0; m < 4; ++m)
#pragma unroll
                    for (int bj = 0; bj < 2; ++bj) { const size_t off = (size_t)(row0 + ai * 128 + m * 16) * DM + col0 + bj * 128; acc[ai][bj][m][0] += *(const f32x4*)(basef + off); acc[ai][bj][m][1] += *(const f32x4*)(basef + off + 4); asm volatile("" ::: "memory"); }
            } else {
                const bf16_t* xrow = xb + (size_t)(row0 + ai * 128) * DM + col0;
#define RES_ADD(m, bj, b) do { acc[ai][bj][m][0] += (f32x4){bf_lo(b.x), bf_hi(b.x), bf_lo(b.y), bf_hi(b.y)}; acc[ai][bj][m][1] += (f32x4){bf_lo(b.z), bf_hi(b.z), bf_lo(b.w), bf_hi(b.w)}; } while (0)
                { const u32x4 p00 = *(const u32x4*)(xrow), p01 = *(const u32x4*)(xrow + 128), p10 = *(const u32x4*)(xrow + (size_t)16 * DM), p11 = *(const u32x4*)(xrow + (size_t)16 * DM + 128);
                  const u32x4 p20 = *(const u32x4*)(xrow + (size_t)32 * DM), p21 = *(const u32x4*)(xrow + (size_t)32 * DM + 128);
                  RES_ADD(0, 0, p00); RES_ADD(0, 1, p01); RES_ADD(1, 0, p10); RES_ADD(1, 1, p11); RES_ADD(2, 0, p20); RES_ADD(2, 1, p21); }
                { const u32x4 p30 = *(const u32x4*)(xrow + (size_t)48 * DM), p31 = *(const u32x4*)(xrow + (size_t)48 * DM + 128); RES_ADD(3, 0, p30); RES_ADD(3, 1, p31); }
#undef RES_ADD
            }
#pragma unroll
            for (int m = 0; m < 4; ++m) {
                const size_t row = (size_t)(row0 + ai * 128 + m * 16);
                float ss = 0.f;
#pragma unroll
                for (int bj = 0; bj < 2; ++bj) {
                    const f32x4 x0 = acc[ai][bj][m][0], x1 = acc[ai][bj][m][1];
                    *(u32x4*)(xb + (size_t)(row0 + ai * 128) * DM + col0 + (size_t)m * 16 * DM + bj * 128) = pack8(x0, x1);
                    ss += (x0[0] * x0[0] + x0[1] * x0[1]) + (x0[2] * x0[2] + x0[3] * x0[3]) + (x1[0] * x1[0] + x1[1] * x1[1]) + (x1[2] * x1[2] + x1[3] * x1[3]);
                }
                ss += __shfl_xor(ss, 16); ss += __shfl_xor(ss, 32);
                if (fq == 0) part[row * 16 + u.pn * 4 + wc] = ss;
            }
        }
    }
};
struct EpiScale {
    bf16_t* O; int ldc; const LAS float* tab; float sc;
    __device__ __forceinline__ void operator()(Acc& acc, const pg8::Unit& u, int wr, int wc, int fr, int fq) const {
        const int row0 = u.pm * 256 + wr * 64 + fr, col0 = u.pn * 256 + wc * 32 + 8 * fq;
        float rs[2][4]; row_rstd(tab, u, wr, fr, rs);
#pragma unroll
        for (int ai = 0; ai < 2; ++ai)
#pragma unroll
            for (int m = 0; m < 4; ++m) {
                const float r = rs[ai][m] * sc;
                bf16_t* rowp = O + (size_t)(row0 + ai * 128 + m * 16) * ldc + col0;
#pragma unroll
                for (int bj = 0; bj < 2; ++bj) *(u32x4*)(rowp + bj * 128) = pack8(acc[ai][bj][m][0] * r, acc[ai][bj][m][1] * r);
            }
    }
};
struct EpiSwiglu {
    bf16_t* H; const LAS float* tab;
    __device__ __forceinline__ void operator()(Acc& acc, const pg8::Unit& u, int wr, int wc, int fr, int fq) const {
        const int row0 = u.pm * 256 + wr * 64 + fr, col0 = u.pn * 128 + wc * 32 + 8 * fq;
        float rs[2][4]; row_rstd(tab, u, wr, fr, rs);
#pragma unroll
        for (int ai = 0; ai < 2; ++ai)
#pragma unroll
            for (int m = 0; m < 4; ++m) {
                const float r = rs[ai][m];
                f32x4 h0, h1;
#pragma unroll
                for (int j = 0; j < 4; ++j) {
                    const float g0 = acc[ai][0][m][0][j] * r, u0 = acc[ai][1][m][0][j] * r, g1 = acc[ai][0][m][1][j] * r, u1 = acc[ai][1][m][1][j] * r;
                    h0[j] = g0 * fast_sigmoid(g0) * u0; h1[j] = g1 * fast_sigmoid(g1) * u1;
                }
                *(u32x4*)(H + (size_t)(row0 + ai * 128 + m * 16) * DFF + col0) = pack8(h0, h1);
            }
    }
};

__device__ const unsigned char T5_BUCKET[128] = {0, 1, 2, 3, 4, 5, 6, 7, 8, 9, 10, 11, 12, 13, 14, 15, 16, 16, 16, 17, 17, 18, 18, 18, 19, 19, 19, 20, 20, 20, 20, 21, 21, 21, 21, 22, 22, 22, 22, 22, 23, 23, 23, 23, 23, 23, 24, 24, 24, 24, 24, 24, 25, 25, 25, 25, 25, 25, 25, 26, 26, 26, 26, 26, 26, 26, 26, 27, 27, 27, 27, 27, 27, 27, 27, 27, 27, 28, 28, 28, 28, 28, 28, 28, 28, 28, 28, 29, 29, 29, 29, 29, 29, 29, 29, 29, 29, 29, 29, 30, 30, 30, 30, 30, 30, 30, 30, 30, 30, 30, 30, 30, 30, 31, 31, 31, 31, 31, 31, 31, 31, 31, 31, 31, 31, 31, 31, 31};

__device__ __forceinline__ v4i16_t vtr(const LAS unsigned char* p) { return __builtin_amdgcn_ds_read_tr16_b64_v4i16((LAS v4i16_t*)p); }

template <int HD, int NQ, int MODE, int STG>
__device__ __forceinline__ void attn_unit(LAS unsigned char* lds, const bf16_t* Qp, int ldq, const bf16_t* Kp, int ldk, const bf16_t* Vp, int ldv, bf16_t* Op, int ldo,
                                          int q0, int t_lo, int t_hi, int bt_head, float sink2) {
    constexpr int KS = HD * 2 + 16, VS = HD * 2 + 32, NKS = HD / 32, NDB = HD / 16, CH = HD / 64, CPR = HD / 8;
    constexpr int TILE_B = 64 * KS + 64 * VS, OFF_BT = STG * TILE_B;
    int tid_ = threadIdx.x; asm volatile("" : "+v"(tid_));
    const int tid = tid_, lane = tid & 63, wid = __builtin_amdgcn_readfirstlane(tid >> 6), ql = lane & 15, kq = lane >> 4;
    const int qw = 16 * NQ * wid, qabs = q0 + qw;
    bf16x8 qf[NQ][NKS];
#pragma unroll
    for (int qb = 0; qb < NQ; ++qb)
#pragma unroll
        for (int ks = 0; ks < NKS; ++ks) qf[qb][ks] = *(const bf16x8*)(Qp + (size_t)(qw + 16 * qb + ql) * ldq + 32 * ks + 8 * kq);
    f32x4 o[NQ][NDB]; float mrun[NQ], lrun[NQ];
#pragma unroll
    for (int qb = 0; qb < NQ; ++qb) { mrun[qb] = (MODE == 1) ? sink2 : -1e30f; lrun[qb] = 0.f;
#pragma unroll
        for (int db = 0; db < NDB; ++db) o[qb][db] = (f32x4){0.f, 0.f, 0.f, 0.f}; }
    u32x4 kr[STG][CH], vr[STG][CH];
#define AT_LOAD(j, t) do { _Pragma("unroll") for (int i = 0; i < CH; ++i) { const int c = tid + 512 * i, row = c / CPR, c8 = c % CPR; \
        kr[j][i] = *(const u32x4*)(Kp + (size_t)(64 * (t) + row) * ldk + 8 * c8); vr[j][i] = *(const u32x4*)(Vp + (size_t)(64 * (t) + row) * ldv + 8 * c8); } } while (0)
#define AT_STORE(j) do { _Pragma("unroll") for (int i = 0; i < CH; ++i) { const int c = tid + 512 * i, row = c / CPR, c8 = c % CPR; \
        *(LAS u32x4*)(lds + (j) * TILE_B + row * KS + 16 * c8) = kr[j][i]; *(LAS u32x4*)(lds + (j) * TILE_B + 64 * KS + row * VS + 16 * c8) = vr[j][i]; } } while (0)
#define AT_COMPUTE(t, TB) do { \
        bool act = true; \
        if (MODE == 1) act = (64 * (t) <= qabs + 16 * NQ - 1) && (64 * (t) + 63 >= qabs - 127); \
        if (act) { \
            const LAS unsigned char* kt = lds + (TB); const LAS unsigned char* vt = kt + 64 * KS; \
            f32x4 s[NQ][4]; \
            _Pragma("unroll") for (int kb = 0; kb < 4; ++kb) \
                _Pragma("unroll") for (int ks = 0; ks < NKS; ++ks) { \
                    const bf16x8 kf = *(const LAS bf16x8*)(kt + (16 * kb + ql) * KS + 64 * ks + 16 * kq); \
                    _Pragma("unroll") for (int qb = 0; qb < NQ; ++qb) s[qb][kb] = __builtin_amdgcn_mfma_f32_16x16x32_bf16(kf, qf[qb][ks], ks == 0 ? (f32x4){0.f, 0.f, 0.f, 0.f} : s[qb][kb], 0, 0, 0); \
                } \
            if (MODE == 1) { \
                const LAS float* BT = (const LAS float*)(lds + OFF_BT) + 128 * bt_head; \
                _Pragma("unroll") for (int qb = 0; qb < NQ; ++qb) \
                    _Pragma("unroll") for (int kb = 0; kb < 4; ++kb) \
                        _Pragma("unroll") for (int r = 0; r < 4; ++r) { const int n = (qabs + 16 * qb + ql) - (64 * (t) + 16 * kb + 4 * kq + r); const bool ok = (unsigned)n < 128u; \
                            const float bv = BT[ok ? n : 0]; s[qb][kb][r] = ok ? s[qb][kb][r] + bv : -INFINITY; } \
            } \
            bf16x8 pb[NQ][2]; \
            _Pragma("unroll") for (int qb = 0; qb < NQ; ++qb) { \
                float mx = fmaxf(fmaxf(s[qb][0][0], s[qb][0][1]), fmaxf(s[qb][0][2], s[qb][0][3])); \
                _Pragma("unroll") for (int kb = 1; kb < 4; ++kb) mx = fmaxf(mx, fmaxf(fmaxf(s[qb][kb][0], s[qb][kb][1]), fmaxf(s[qb][kb][2], s[qb][kb][3]))); \
                mx = fmaxf(mx, __shfl_xor(mx, 16)); mx = fmaxf(mx, __shfl_xor(mx, 32)); \
                const float mn = fmaxf(mrun[qb], mx), al = __builtin_amdgcn_exp2f(mrun[qb] - mn); mrun[qb] = mn; \
                float ps = 0.f; \
                _Pragma("unroll") for (int kb = 0; kb < 4; ++kb) \
                    _Pragma("unroll") for (int r = 0; r < 4; ++r) { const float p = __builtin_amdgcn_exp2f(s[qb][kb][r] - mn); s[qb][kb][r] = p; ps += p; } \
                lrun[qb] = lrun[qb] * al + ps; \
                _Pragma("unroll") for (int db = 0; db < NDB; ++db) o[qb][db] *= al; \
                _Pragma("unroll") for (int s2 = 0; s2 < 2; ++s2) { const u32x4 w = pack8(s[qb][2 * s2], s[qb][2 * s2 + 1]); pb[qb][s2] = __builtin_bit_cast(bf16x8, w); } \
            } \
            _Pragma("unroll") for (int db = 0; db < NDB; ++db) \
                _Pragma("unroll") for (int s2 = 0; s2 < 2; ++s2) { \
                    const LAS unsigned char* vb = vt + (32 * s2 + 4 * kq + (ql >> 2)) * VS + (16 * db + 4 * (ql & 3)) * 2; \
                    const v4i16_t lo = vtr(vb), hi = vtr(vb + 16 * VS); \
                    const bf16x8 vf = {lo[0], lo[1], lo[2], lo[3], hi[0], hi[1], hi[2], hi[3]}; \
                    _Pragma("unroll") for (int qb = 0; qb < NQ; ++qb) o[qb][db] = __builtin_amdgcn_mfma_f32_16x16x32_bf16(vf, pb[qb][s2], o[qb][db], 0, 0, 0); \
                } \
        } } while (0)
    if (STG == 1) {
        AT_LOAD(0, t_lo);
        for (int t = t_lo; t < t_hi; ++t) {
            __syncthreads();
            AT_STORE(0);
            __syncthreads();
            if (t + 1 < t_hi) AT_LOAD(0, t + 1);
            AT_COMPUTE(t, 0);
        }
    } else {
        for (int tb = t_lo; tb < t_hi; tb += STG) {
#pragma unroll
            for (int j = 0; j < STG; ++j) if (tb + j < t_hi) AT_LOAD(j, tb + j);
            __syncthreads();
#pragma unroll
            for (int j = 0; j < STG; ++j) if (tb + j < t_hi) AT_STORE(j);
            __syncthreads();
#pragma unroll
            for (int j = 0; j < STG; ++j) if (tb + j < t_hi) AT_COMPUTE(tb + j, j * TILE_B);
        }
    }
#undef AT_LOAD
#undef AT_STORE
#undef AT_COMPUTE
#pragma unroll
    for (int qb = 0; qb < NQ; ++qb) {
        float l = lrun[qb]; l += __shfl_xor(l, 16); l += __shfl_xor(l, 32);
        if (MODE == 1) l += __builtin_amdgcn_exp2f(sink2 - mrun[qb]);
        const float inv = 1.0f / l;
        bf16_t* orow = Op + (size_t)(qw + 16 * qb + ql) * ldo + 4 * kq;
#pragma unroll
        for (int db = 0; db < NDB; ++db) { u32x2 w; w.x = cvt_pk_bf16(o[qb][db][0] * inv, o[qb][db][1] * inv); w.y = cvt_pk_bf16(o[qb][db][2] * inv, o[qb][db][3] * inv); *(u32x2*)(orow + 16 * db) = w; }
    }
}

namespace fox {
using bf16=__hip_bfloat16;
using s16x4=__attribute__((ext_vector_type(4)))short;
using f32x16=__attribute__((ext_vector_type(16)))float;
constexpr int NHEAD=8,SEQ=8192,D=64,DM=PROJ_LD;
constexpr int NW=8,QBLK=32,QB=QBLK*NW,KVBLK=64,NQB=SEQ/QB;
__device__ __forceinline__ int crow(int r,int hi){return (r&3)+8*(r>>2)+4*hi;}
#define SBAR() __builtin_amdgcn_sched_barrier(0)
__device__ __forceinline__ void cmask(f32x16&p0,f32x16&p1,int jb,int qrel,int hi){
  const float NEG=-INFINITY; int kb=64*jb+4*hi;
  #pragma unroll
  for(int r=0;r<16;++r){int kv=kb+(r&3)+8*(r>>2); if(kv>qrel)p0[r]=NEG; if(kv+32>qrel)p1[r]=NEG;}
}

constexpr int NSLOT=3, SLOTB=9216, XOFF=8192;
constexpr int LDS_K=0, LDS_V=NSLOT*SLOTB, LDS_WS=2*NSLOT*SLOTB, LDS_OST=LDS_WS+NW*64*4, LDS_BYTES=LDS_OST+NW*4096;
constexpr float C2=0.125f*1.4426950408889634f;
__device__ __forceinline__ void glds16(const void*gsrc,unsigned lds_dst){unsigned keep;
  asm volatile("s_mov_b32 %0, m0\n\ts_mov_b32 m0, %2\n\ts_nop 0\n\tglobal_load_lds_dwordx4 %1, off\n\ts_mov_b32 m0, %0":"=&s"(keep):"v"(gsrc),"s"(lds_dst):"memory");}
__device__ __forceinline__ float max3f(float a,float b,float c){float r;asm("v_max3_f32 %0, %1, %2, %3":"=v"(r):"v"(a),"v"(b),"v"(c));return r;}
__device__ __forceinline__ float max2f(float a,float b){float r;asm("v_max_f32_e32 %0, %1, %2":"=v"(r):"v"(a),"v"(b));return r;}
__device__ __forceinline__ float fadd_s(float a,float b){float r;asm("v_add_f32_e32 %0, %1, %2":"=v"(r):"v"(a),"v"(b));return r;}
__device__ __forceinline__ float fsub_s(float a,float b){float r;asm("v_sub_f32_e32 %0, %1, %2":"=v"(r):"v"(a),"v"(b));return r;}
typedef float f32x2_t __attribute__((ext_vector_type(2))); typedef __bf16 bf16x2_t __attribute__((ext_vector_type(2)));
__device__ __forceinline__ unsigned cvtpk_s(float lo,float hi){f32x2_t v={lo,hi};bf16x2_t b=__builtin_convertvector(v,bf16x2_t);return __builtin_bit_cast(unsigned,b);}
#define WAIT_BAR(N) asm volatile("s_waitcnt vmcnt(" #N ") lgkmcnt(0)\n\ts_barrier":::"memory")
#define WAIT_BARK2() do{ if(wid==0){WAIT_BAR(3);} else {WAIT_BAR(2);} }while(0)

__device__ __forceinline__ void qkt(f32x16&p0,f32x16&p1,const char*Kslot,const bf16x8*qr,const bf16x8&qxa,const bf16x8&qxb,int r32,int hi,int lane){
  const f32x16 z16=f32x16{};
  const char*kb=Kslot+hi*1024+r32*16;
  #pragma unroll
  for(int d0=0;d0<4;++d0){
    const bf16x8 b0=*reinterpret_cast<const bf16x8*>(kb+d0*2048);
    const bf16x8 b1=*reinterpret_cast<const bf16x8*>(kb+d0*2048+512);
    if(d0==0){p0=__builtin_amdgcn_mfma_f32_32x32x16_bf16(b0,qr[0],z16,0,0,0);p1=__builtin_amdgcn_mfma_f32_32x32x16_bf16(b1,qr[0],z16,0,0,0);}
    else{p0=__builtin_amdgcn_mfma_f32_32x32x16_bf16(b0,qr[d0],p0,0,0,0);p1=__builtin_amdgcn_mfma_f32_32x32x16_bf16(b1,qr[d0],p1,0,0,0);}}
  const bf16x8 kx=*reinterpret_cast<const bf16x8*>(Kslot+XOFF+lane*16);
  p0=__builtin_amdgcn_mfma_f32_32x32x16_bf16(kx,qxa,p0,0,0,0);p1=__builtin_amdgcn_mfma_f32_32x32x16_bf16(kx,qxb,p1,0,0,0);
}
typedef __attribute__((address_space(3))) const char* lds_cptr;
typedef short v4i16_t __attribute__((ext_vector_type(4)));
__device__ __forceinline__ void kload8(bf16x8*kf,lds_cptr kp){
  kf[0]=*(const __attribute__((address_space(3))) bf16x8*)(kp);      kf[1]=*(const __attribute__((address_space(3))) bf16x8*)(kp+512);
  kf[2]=*(const __attribute__((address_space(3))) bf16x8*)(kp+2048); kf[3]=*(const __attribute__((address_space(3))) bf16x8*)(kp+2560);
  kf[4]=*(const __attribute__((address_space(3))) bf16x8*)(kp+4096); kf[5]=*(const __attribute__((address_space(3))) bf16x8*)(kp+4608);
  kf[6]=*(const __attribute__((address_space(3))) bf16x8*)(kp+6144); kf[7]=*(const __attribute__((address_space(3))) bf16x8*)(kp+6656);
}
__device__ __forceinline__ void kload2(bf16x8*kf,lds_cptr kp,int j){ kf[2*j]=*(const __attribute__((address_space(3))) bf16x8*)(kp+j*2048); kf[2*j+1]=*(const __attribute__((address_space(3))) bf16x8*)(kp+j*2048+512); }
__device__ __forceinline__ s16x4 vtr(lds_cptr p){ return __builtin_bit_cast(s16x4,__builtin_amdgcn_ds_read_tr16_b64_v4i16((__attribute__((address_space(3))) v4i16_t*)p)); }
__device__ __forceinline__ float rowmax(const f32x16&p0,const f32x16&p1){
  float a=max3f(p0[0],p0[1],p1[0]),b=max3f(p0[2],p0[3],p1[1]);a=max3f(a,p1[2],p1[3]);
  #pragma unroll
  for(int r=4;r<16;r+=4){a=max3f(a,p0[r],p0[r+1]);b=max3f(b,p0[r+2],p0[r+3]);a=max3f(a,p1[r],p1[r+1]);b=max3f(b,p1[r+2],p1[r+3]);}
  const float m=max2f(a,b);
  auto rr=__builtin_amdgcn_permlane32_swap(__float_as_uint(m),__float_as_uint(m),false,false);
  return max2f(__uint_as_float(rr[0]),__uint_as_float(rr[1]));
}
__device__ __forceinline__ void pv(f32x16*o,int vb,bf16x8 pa0,bf16x8 pa1,bf16x8 pa2,bf16x8 pa3){
  #pragma unroll
  for(int d0=0;d0<2;++d0){s16x4 lo[4],hi[4];
    #pragma unroll
    for(int ks=0;ks<4;++ks){
      asm volatile("ds_read_b64_tr_b16 %0,%1 offset:%c2":"=&v"(lo[ks]):"v"(vb),"i"(d0*4096+ks*1024):"memory");
      asm volatile("ds_read_b64_tr_b16 %0,%1 offset:%c2":"=&v"(hi[ks]):"v"(vb),"i"(d0*4096+ks*1024+512):"memory");}
    asm volatile("s_waitcnt lgkmcnt(0)":::"memory");SBAR();
    #define PK(k) (bf16x8){lo[k][0],lo[k][1],lo[k][2],lo[k][3],hi[k][0],hi[k][1],hi[k][2],hi[k][3]}
    o[d0]=__builtin_amdgcn_mfma_f32_32x32x16_bf16(pa0,PK(0),o[d0],0,0,0);
    o[d0]=__builtin_amdgcn_mfma_f32_32x32x16_bf16(pa1,PK(1),o[d0],0,0,0);
    o[d0]=__builtin_amdgcn_mfma_f32_32x32x16_bf16(pa2,PK(2),o[d0],0,0,0);
    o[d0]=__builtin_amdgcn_mfma_f32_32x32x16_bf16(pa3,PK(3),o[d0],0,0,0);
    #undef PK
  }
}

#ifndef ATTN_STORE16
#define ATTN_STORE16(p,v) (*(u32x4*)(p)=(v))
#endif
template<int THRL> __device__ __forceinline__ void attn_unit(int b,int h,int qb,const bf16*Q,const bf16*__restrict__ K,const bf16*__restrict__ V,const bf16*__restrict__ KX,bf16*O,char*shm,int t0){
  int tid_=threadIdx.x; asm volatile("":"+v"(tid_)); const int tid=tid_,lane=tid&63,r32=lane&31,hi=lane>>5; const int wid=__builtin_amdgcn_readfirstlane(tid>>6);
  const long rowbase=(long)b*SEQ; const int q0=qb*QB;
  const bf16*Qw=Q+(rowbase+q0+wid*QBLK)*DM+h*D;
  const bf16*Kh=K+(rowbase+(long)t0*KVBLK)*DM+h*D,*Vh=V+(rowbase+(long)t0*KVBLK)*DM+h*D;
  const unsigned lds0=(unsigned)(uintptr_t)shm;
  float*wsf=(float*)(shm+LDS_WS)+wid*64;
  const bf16*ksrc=Kh+(long)lane*DM+wid*8;
  const bf16*vsrc=Vh+(long)(16*(wid&3)+(lane>>2))*DM+(wid>>2)*32+(lane&3)*8;
  const bf16*xsrc=KX+((long)t0*KVBLK+lane)*8;
  const unsigned kdst=lds0+LDS_K+wid*1024, vdst=lds0+LDS_V+wid*1024;
  #define DMA_K(t,slot) do{ glds16(ksrc+(long)(t)*KVBLK*DM,(unsigned)__builtin_amdgcn_readfirstlane(kdst+(slot))); if(wid==0) glds16(xsrc+(long)(t)*KVBLK*8,(unsigned)__builtin_amdgcn_readfirstlane(lds0+LDS_K+XOFF+(slot))); }while(0)
  #define DMA_V(t,slot) glds16(vsrc+(long)(t)*KVBLK*DM,(unsigned)__builtin_amdgcn_readfirstlane(vdst+(slot)))
  const int vb0=(int)(lds0+LDS_V)+((lane>>4)&1)*32+(lane&3)*8+(4*hi+((lane&15)>>2))*64;
  const char*Kbase=shm+LDS_K; bf16x8 kf[8];
  const lds_cptr shm3=(lds_cptr)shm; const lds_cptr xp0=shm3+LDS_K+XOFF+lane*16; const lds_cptr kp0=shm3+LDS_K+hi*1024+r32*16; const lds_cptr vp0=shm3+LDS_V+((lane>>4)&1)*32+(lane&3)*8+(4*hi+((lane&15)>>2))*64;
  const int NT=(q0+QB)/KVBLK-t0;
  DMA_K(0,0);DMA_V(0,0);DMA_K(1,SLOTB);
  bf16x8 qr[4];
  #pragma unroll
  for(int d0=0;d0<4;++d0)qr[d0]=*reinterpret_cast<const bf16x8*>(&Qw[(long)r32*DM+d0*16+hi*8]);
  float mhat=0.f,l_reg=0.f;f32x16 o[2];o[0]=f32x16{};o[1]=f32x16{};bf16x8 qxa,qxb,kxf; const f32x16 z16=f32x16{};
  #define SETQX(mh) do{ const float v_=-(mh); const unsigned a_=cvtpk_s(v_,0.f)&0xffffu; const float r1_=v_-__uint_as_float(a_<<16); const unsigned b_=cvtpk_s(r1_,0.f)&0xffffu; const float r2_=r1_-__uint_as_float(b_<<16); const unsigned c_=cvtpk_s(r2_,0.f)&0xffffu; \
    const u32x4 w_={0x3f803f80u,0x3f80u|(a_<<16),b_|(c_<<16),0u}; const u32x4 z_={0u,0u,0u,0u}; qxa=__builtin_bit_cast(bf16x8,hi?z_:w_); qxb=__builtin_bit_cast(bf16x8,hi?w_:z_); asm volatile("":"+v"(qxa),"+v"(qxb)); }while(0)
  SETQX(0.f);
  const int qrel=wid*QBLK+r32;
  #define CMASK(P0,P1,t) do{int jb_=(t)-(NT-4); if(jb_>=0)cmask(P0,P1,jb_,qrel,hi);}while(0)
  bool resc=false;
  #define START(P0,P1) do{ const float rm=rowmax(P0,P1); resc=false; \
    { const float dl=rm; mhat=fadd_s(mhat,dl); \
      _Pragma("unroll") for(int r=0;r<16;++r){P0[r]=fsub_s(P0[r],dl);P1[r]=fsub_s(P1[r],dl);} \
      SETQX(mhat); } \
    _Pragma("unroll") for(int r=0;r<16;++r)P0[r]=__builtin_amdgcn_exp2f(P0[r]); }while(0)
  #define RESC() do{ if(resc){ asm volatile("s_waitcnt lgkmcnt(0)":::"memory"); \
      _Pragma("unroll") for(int d_=0;d_<2;++d_) _Pragma("unroll") for(int r=0;r<16;++r)o[d_][r]*=wsf[crow(r,hi)]; } }while(0)
  f32x16 pA0,pA1,pB0,pB1;
  int sl_prev=0,sl_cur=0,sl_next=SLOTB;
  #define ROT() do{sl_prev=sl_cur;sl_cur=sl_next;sl_next=(sl_next==(NSLOT-1)*SLOTB)?0:sl_next+SLOTB;}while(0)
  DMA_K(2,2*SLOTB);
  WAIT_BAR(3);
  qkt(pA0,pA1,Kbase,qr,qxa,qxb,r32,hi,lane);asm volatile("s_nop 15\n\ts_nop 7":"+v"(pA0),"+v"(pA1));CMASK(pA0,pA1,0);
  START(pA0,pA1);
  _Pragma("unroll") for(int r=0;r<16;++r)pA1[r]=__builtin_amdgcn_exp2f(pA1[r]);
  WAIT_BAR(0);
  DMA_K(3,0);DMA_V(1,SLOTB);
  ROT();
  kload8(kf,kp0+sl_cur); kxf=*(const __attribute__((address_space(3))) bf16x8*)(xp0+sl_cur);
  WAIT_BARK2();
  s16x4 vlo[8],vhi[8]; u32x4 pw0,pw1,pw2,pw3;
  #define PKW(P,B) cvtpk_s(P[B],P[B+1])
  #define PAF(k) __builtin_bit_cast(bf16x8,pw##k)
  #define VFR(i) (bf16x8){vlo[i][0],vlo[i][1],vlo[i][2],vlo[i][3],vhi[i][0],vhi[i][1],vhi[i][2],vhi[i][3]}
  #define PIN(x) asm volatile("":"+v"(x))
  #define MX3(a,b,c) __builtin_fmaxf(__builtin_fmaxf((a),(b)),(c))
  #define GAPA(MF,A0,A1,A2,A3,W0,W1,PW) do{ MF; sacc+=A0; sacc+=A1; sacc+=A2; sacc+=A3; PIN(sacc); W0; W1; PIN(PW); SBAR(); }while(0)
  #define EX(v) __builtin_amdgcn_exp2f(v)
  #define GAPB(MF,X,B) do{ MF; X[B]=EX(X[B]); X[B+1]=EX(X[B+1]); X[B+2]=EX(X[B+2]); X[B+3]=EX(X[B+3]); PIN(X); SBAR(); }while(0)
  #define VRD(i) do{ vlo[i]=vtr(vp_+(((i)>>2)*4096+((i)&3)*1024)); vhi[i]=vtr(vp_+(((i)>>2)*4096+((i)&3)*1024+512)); }while(0)
  #define KRD(G,j) do{ if(G){ kload2(kf,kp0+sl_next,j); if((j)==3) kxf=*(const __attribute__((address_space(3))) bf16x8*)(xp0+sl_next); SBAR(); } }while(0)
  #define STEP(C0,C1,P0,P1,t,GK,GV,GL) do{ SBAR(); \
    const lds_cptr vp_=vp0+sl_prev; \
    VRD(0); SBAR(); float sacc=(P0[0]+P0[1]); \
    GAPA(C0=__builtin_amdgcn_mfma_f32_32x32x16_bf16(kf[0],qr[0],z16,0,0,0), P0[2],P0[3],P0[4],P0[5],     pw0[0]=PKW(P0,0), pw0[1]=PKW(P0,2), pw0); \
    VRD(4); SBAR(); GAPA(C1=__builtin_amdgcn_mfma_f32_32x32x16_bf16(kf[1],qr[0],z16,0,0,0), P0[6],P0[7],P0[8],P0[9],     pw0[2]=PKW(P0,4), pw0[3]=PKW(P0,6), pw0); \
    VRD(1); SBAR(); GAPA(C0=__builtin_amdgcn_mfma_f32_32x32x16_bf16(kf[2],qr[1],C0,0,0,0),   P0[10],P0[11],P0[12],P0[13], pw1[0]=PKW(P0,8), pw1[1]=PKW(P0,10), pw1); \
    VRD(5); SBAR(); GAPA(C1=__builtin_amdgcn_mfma_f32_32x32x16_bf16(kf[3],qr[1],C1,0,0,0),   P0[14],P0[15],P1[0],P1[1],   pw1[2]=PKW(P0,12),pw1[3]=PKW(P0,14), pw1); \
    VRD(2); SBAR(); GAPA(C0=__builtin_amdgcn_mfma_f32_32x32x16_bf16(kf[4],qr[2],C0,0,0,0),   P1[2],P1[3],P1[4],P1[5],     pw2[0]=PKW(P1,0), pw2[1]=PKW(P1,2), pw2); \
    VRD(6); SBAR(); GAPA(C1=__builtin_amdgcn_mfma_f32_32x32x16_bf16(kf[5],qr[2],C1,0,0,0),   P1[6],P1[7],P1[8],P1[9],     pw2[2]=PKW(P1,4), pw2[3]=PKW(P1,6), pw2); \
    VRD(3); SBAR(); GAPA(C0=__builtin_amdgcn_mfma_f32_32x32x16_bf16(kf[6],qr[3],C0,0,0,0),   P1[10],P1[11],P1[12],P1[13], pw3[0]=PKW(P1,8), pw3[1]=PKW(P1,10), pw3); \
    VRD(7); SBAR(); GAPA(C1=__builtin_amdgcn_mfma_f32_32x32x16_bf16(kf[7],qr[3],C1,0,0,0),   P1[14],P1[15],0.f,0.f,       pw3[2]=PKW(P1,12),pw3[3]=PKW(P1,14), pw3); \
    C0=__builtin_amdgcn_mfma_f32_32x32x16_bf16(kxf,qxa,C0,0,0,0); C1=__builtin_amdgcn_mfma_f32_32x32x16_bf16(kxf,qxb,C1,0,0,0); SBAR(); \
    l_reg+=sacc; \
    if(GK){DMA_K((t)+3,sl_cur);} if(GV){DMA_V((t)+1,sl_next);} \
    CMASK(C0,C1,t); \
    { float a=MX3(C0[0],C0[1],C1[0]),b=MX3(C0[2],C0[3],C1[1]); a=MX3(a,C1[2],C1[3]); \
      _Pragma("unroll") for(int r=4;r<16;r+=4){a=MX3(a,C0[r],C0[r+1]);b=MX3(b,C0[r+2],C0[r+3]);a=MX3(a,C1[r],C1[r+1]);b=MX3(b,C1[r+2],C1[r+3]);} \
      float rm=__builtin_fmaxf(a,b); { auto rr=__builtin_amdgcn_permlane32_swap(__float_as_uint(rm),__float_as_uint(rm),false,false); rm=__builtin_fmaxf(__uint_as_float(rr[0]),__uint_as_float(rr[1])); } \
      resc=false; \
      if(__builtin_expect(__any(rm>(float)THRL),0)){ const float dl=__builtin_fmaxf(rm,0.f); mhat+=dl; \
        _Pragma("unroll") for(int r=0;r<16;++r){C0[r]-=dl;C1[r]-=dl;} \
        SETQX(mhat); \
        const float f=__builtin_amdgcn_exp2f(-dl); l_reg*=f; if(hi==0)wsf[r32]=f; resc=true; } } \
    SBAR(); \
    GAPB(o[0]=__builtin_amdgcn_mfma_f32_32x32x16_bf16(PAF(0),VFR(0),o[0],0,0,0), C0,0); \
    GAPB(o[1]=__builtin_amdgcn_mfma_f32_32x32x16_bf16(PAF(0),VFR(4),o[1],0,0,0), C0,4); \
    KRD(GL,0); GAPB(o[0]=__builtin_amdgcn_mfma_f32_32x32x16_bf16(PAF(1),VFR(1),o[0],0,0,0), C0,8); \
    KRD(GL,1); GAPB(o[1]=__builtin_amdgcn_mfma_f32_32x32x16_bf16(PAF(1),VFR(5),o[1],0,0,0), C0,12); \
    KRD(GL,2); GAPB(o[0]=__builtin_amdgcn_mfma_f32_32x32x16_bf16(PAF(2),VFR(2),o[0],0,0,0), C1,0); \
    KRD(GL,3); GAPB(o[1]=__builtin_amdgcn_mfma_f32_32x32x16_bf16(PAF(2),VFR(6),o[1],0,0,0), C1,4); \
    GAPB(o[0]=__builtin_amdgcn_mfma_f32_32x32x16_bf16(PAF(3),VFR(3),o[0],0,0,0), C1,8); \
    GAPB(o[1]=__builtin_amdgcn_mfma_f32_32x32x16_bf16(PAF(3),VFR(7),o[1],0,0,0), C1,12); \
    }while(0)
  int t=1;
  #undef CMASK
  #define CMASK(P0,P1,t) do{}while(0)
  for(;t+5<NT;t+=2){
    STEP(pB0,pB1,pA0,pA1,t,true,true,true);     WAIT_BARK2(); RESC(); ROT();
    STEP(pA0,pA1,pB0,pB1,t+1,true,true,true);   WAIT_BARK2(); RESC(); ROT();
  }
  #undef CMASK
  #define CMASK(P0,P1,t) do{int jb_=(t)-(NT-4); if(jb_>=0)cmask(P0,P1,jb_,qrel,hi);}while(0)
  #define ENDW(tt) do{ if((tt)+3<NT){WAIT_BARK2();} else if((tt)+2<NT){WAIT_BAR(1);} else {WAIT_BAR(0);} }while(0)
  for(;t+1<NT;t+=2){
    STEP(pB0,pB1,pA0,pA1,t,(t+3<NT),(t+1<NT),(t+1<NT));       ENDW(t);   RESC(); ROT();
    STEP(pA0,pA1,pB0,pB1,t+1,(t+4<NT),(t+2<NT),(t+2<NT));     ENDW(t+1); RESC(); ROT();
  }
  STEP(pB0,pB1,pA0,pA1,NT-1,false,false,false); RESC();
  { float sacc=pB0[0]+pB0[1]; _Pragma("unroll") for(int r=2;r<16;++r)sacc+=pB0[r]; _Pragma("unroll") for(int r=0;r<16;++r)sacc+=pB1[r]; l_reg+=sacc;
    pw0=(u32x4){PKW(pB0,0),PKW(pB0,2),PKW(pB0,4),PKW(pB0,6)};pw1=(u32x4){PKW(pB0,8),PKW(pB0,10),PKW(pB0,12),PKW(pB0,14)};pw2=(u32x4){PKW(pB1,0),PKW(pB1,2),PKW(pB1,4),PKW(pB1,6)};pw3=(u32x4){PKW(pB1,8),PKW(pB1,10),PKW(pB1,12),PKW(pB1,14)};
    SBAR(); pv(o,vb0+sl_cur,PAF(0),PAF(1),PAF(2),PAF(3)); }
  #undef PKW
  #undef PAF
  #undef VFR
  #undef PIN
  #undef MX3
  #undef GAPA
  #undef GAPB
  #undef EX
  #undef VRD
  #undef KRD
  #undef STEP
  #undef ENDW
  {auto rr=__builtin_amdgcn_permlane32_swap(__float_as_uint(l_reg),__float_as_uint(l_reg),false,false);l_reg=__uint_as_float(rr[0])+__uint_as_float(rr[1]);}
  if(hi==0)wsf[32+r32]=l_reg;asm volatile("s_waitcnt lgkmcnt(0)":::"memory");
  float rli[16];
  #pragma unroll
  for(int r=0;r<16;++r)rli[r]=__builtin_amdgcn_rcpf(wsf[32+crow(r,hi)]);
  bf16*Ow=O+(rowbase+q0+wid*QBLK)*DM+h*D;
  { bf16*stg=(bf16*)(shm+LDS_OST)+wid*2048;
    #pragma unroll
    for(int r=0;r<16;++r){const int orow=crow(r,hi);
      #pragma unroll
      for(int d0=0;d0<2;++d0)stg[orow*64+d0*32+r32]=__float2bfloat16(o[d0][r]*rli[r]);}
    asm volatile("s_waitcnt lgkmcnt(0)":::"memory");
    #pragma unroll
    for(int i=0;i<4;++i){const int row=i*8+(lane>>3),ch=lane&7; const u32x4 v=*(const u32x4*)(stg+row*64+ch*8); ATTN_STORE16(Ow+(long)row*DM+ch*8,v);} }
  asm volatile("s_waitcnt lgkmcnt(0)\n\ts_barrier":::"memory");
  #undef DMA_K
  #undef DMA_V
  #undef CMASK
  #undef START
  #undef RESC
  #undef ROT
  #undef SETQX
}
constexpr int ATTN_LDS_BYTES=LDS_BYTES;
#undef SBAR
#undef WAIT_BAR
#undef WAIT_BARK2
}

__device__ __forceinline__ float wave_sum(float v) {
#pragma unroll
    for (int o = 1; o < 64; o <<= 1) v += __shfl_xor(v, o);
    return v;
}
__device__ __forceinline__ void tr_item(const float* W, int ldw, int src_col0, int nvalid, const float* g, bf16_t* WT, int ldt, int dst_row0, int dst_col0, int k0, LAS float* scr, int lane) {
    const int ks = lane >> 4, n4 = (lane & 15) * 4;
    f32x4 v[16];
#pragma unroll
    for (int i = 0; i < 16; ++i) v[i] = (n4 < nvalid) ? *(const f32x4*)(W + (size_t)(k0 + 4 * i + ks) * ldw + src_col0 + n4) : (f32x4){0.f, 0.f, 0.f, 0.f};
#pragma unroll
    for (int i = 0; i < 16; ++i) { const int kk = 4 * i + ks; const float gg = g ? g[k0 + kk] : 1.0f;
        scr[kk * 65 + n4] = v[i][0] * gg; scr[kk * 65 + n4 + 1] = v[i][1] * gg; scr[kk * 65 + n4 + 2] = v[i][2] * gg; scr[kk * 65 + n4 + 3] = v[i][3] * gg; }
    asm volatile("s_waitcnt lgkmcnt(0)" ::: "memory");
    const int c = lane & 7;
#pragma unroll
    for (int j = 0; j < 8; ++j) { const int n = (lane >> 3) + 8 * j; const LAS float* s = scr + (8 * c) * 65 + n;
        u32x4 o; o.x = cvt_pk_bf16(s[0 * 65], s[1 * 65]); o.y = cvt_pk_bf16(s[2 * 65], s[3 * 65]); o.z = cvt_pk_bf16(s[4 * 65], s[5 * 65]); o.w = cvt_pk_bf16(s[6 * 65], s[7 * 65]);
        *(u32x4*)(WT + (size_t)(dst_row0 + n) * ldt + dst_col0 + k0 + 8 * c) = o; }
    asm volatile("s_waitcnt lgkmcnt(0)" ::: "memory");
}
__device__ __forceinline__ void tr_job(const float* W, int ldw, int K, int src_col0, int nrows, int nvalid_total, const float* g, bf16_t* WT, int ldt, int dst_row0, int dst_col0, LAS float* scr, int lane, int gw, int NGW) {
    const int nblk = nrows / 64, nit = (K / 64) * nblk;
    for (int it = gw; it < nit; it += NGW) { const int kb = it / nblk, nb = it % nblk; int nv = nvalid_total - 64 * nb; nv = nv > 64 ? 64 : nv;
        tr_item(W, ldw, src_col0 + 64 * nb, nv, g, WT, ldt, dst_row0 + 64 * nb, dst_col0, 64 * kb, scr, lane); }
}
template <int NR> __device__ __forceinline__ void rows_to_bf16(const float* x, bf16_t* o, float* p, int m0, int rs, int lane) {
    f32x4 v[NR][4];
#pragma unroll
    for (int r = 0; r < NR; ++r) { const f32x4* xr = (const f32x4*)(x + (size_t)(m0 + r * rs) * DM) + lane;
#pragma unroll
        for (int j = 0; j < 4; ++j) v[r][j] = xr[64 * j]; }
#pragma unroll
    for (int r = 0; r < NR; ++r) {
        float s = 0.f;
#pragma unroll
        for (int j = 0; j < 4; ++j) s += (v[r][j][0] * v[r][j][0] + v[r][j][1] * v[r][j][1]) + (v[r][j][2] * v[r][j][2] + v[r][j][3] * v[r][j][3]);
        s = wave_sum(s);
        u32x2* o8 = (u32x2*)(o + (size_t)(m0 + r * rs) * DM) + lane;
#pragma unroll
        for (int j = 0; j < 4; ++j) { u32x2 w; w.x = cvt_pk_bf16(v[r][j][0], v[r][j][1]); w.y = cvt_pk_bf16(v[r][j][2], v[r][j][3]); o8[64 * j] = w; }
        if (lane < 16) p[(size_t)(m0 + r * rs) * 16 + lane] = (lane == 0) ? s : 0.f;
    }
}


#define RLX_AGENT __ATOMIC_RELAXED, __HIP_MEMORY_SCOPE_AGENT
#define XB_TMO      128
#define XB_XCNT(j)  (256  + 64 * (j))
#define XB_XSUB(j)  (1280 + 64 * (j))
#define XB_XGEN(j)  (2304 + 64 * (j))
#define XB_TOP      3328
#define XB_TOPGEN   3392
#define XCD_BAR_WORDS 3456
#define XB_SPIN_CAP (1u << 18)

__device__ __forceinline__ unsigned xb_ld(unsigned* p)              { return __hip_atomic_load(p, __ATOMIC_RELAXED, __HIP_MEMORY_SCOPE_AGENT); }
__device__ __forceinline__ unsigned xb_add(unsigned* p, unsigned v) { return __hip_atomic_fetch_add(p, v, __ATOMIC_RELAXED, __HIP_MEMORY_SCOPE_AGENT); }
__device__ __forceinline__ unsigned xb_xcc_id() { return (unsigned)__builtin_amdgcn_s_getreg((3 << 11) | 20) & 0xFu; }
#define XB_SPIN(cond, bar) do { unsigned _sp = 0; while (cond) { __builtin_amdgcn_s_sleep(1); \
    if ((++_sp & 255u) == 0u) { if (xb_ld(&(bar)[XB_TMO])) break; if (_sp > XB_SPIN_CAP) { atomicAdd(&(bar)[XB_TMO], 1u); break; } } } } while (0)

struct XcdBarrier {
    unsigned* bar; unsigned x;
    volatile LAS unsigned* st;
};

__device__ __forceinline__ XcdBarrier xcd_barrier_post(unsigned* bar, volatile LAS unsigned* st) {
    XcdBarrier b; b.bar = bar; b.x = xb_xcc_id(); b.st = st;
    if (threadIdx.x == 0) (void)xb_add(&bar[XB_XCNT(b.x)], 1u);
    return b;
}
__device__ __forceinline__ void xcd_barrier_complete(unsigned* bar, unsigned x, unsigned& nloc, unsigned& nx) {
    const unsigned G = gridDim.x * gridDim.y * gridDim.z;
    unsigned sum, cnt, mine, sp = 0u;
    for (;;) {
        sum = 0u; cnt = 0u; mine = 0u;
#pragma unroll
        for (unsigned j = 0; j < 16; ++j) { const unsigned c = xb_ld(&bar[XB_XCNT(j)]); sum += c; cnt += (c > 0u) ? 1u : 0u; mine = (j == x) ? c : mine; }
        if (sum == G) break;
        __builtin_amdgcn_s_sleep(1);
        if ((++sp & 255u) == 0u) { if (xb_ld(&bar[XB_TMO])) break; if (sp > XB_SPIN_CAP) { atomicAdd(&bar[XB_TMO], 1u); break; } }
    }
    nloc = mine > 0u ? mine : 1u; nx = cnt > 0u ? cnt : 1u;
}

__device__ __forceinline__ void xcd_barrier(const XcdBarrier& b) {
    asm volatile("s_waitcnt vmcnt(0)" ::: "memory");
    __syncthreads();
    if (threadIdx.x == 0) {
        unsigned* bar = b.bar;
        __builtin_amdgcn_s_waitcnt(0);
        unsigned nloc = b.st[0], nx = b.st[1];
        if (nloc == 0u) { xcd_barrier_complete(bar, b.x, nloc, nx); b.st[0] = nloc; b.st[1] = nx; }
        const unsigned old = xb_add(&bar[XB_XSUB(b.x)], 1u);
        const unsigned gen = old / nloc;
        if (old + 1u == (gen + 1u) * nloc) {
            __builtin_amdgcn_fence(__ATOMIC_RELEASE, "agent");
            asm volatile("s_waitcnt vmcnt(0)" ::: "memory");
            const unsigned og = xb_add(&bar[XB_TOP], 1u);
            const unsigned tg = og / nx;
            if (og + 1u == (tg + 1u) * nx) xb_add(&bar[XB_TOPGEN], 1u);
            else XB_SPIN(xb_ld(&bar[XB_TOPGEN]) == tg, bar);
            __builtin_amdgcn_fence(__ATOMIC_ACQUIRE, "agent");
            xb_add(&bar[XB_XGEN(b.x)], 1u);
            asm volatile("s_waitcnt vmcnt(0)" ::: "memory");
        } else {
            XB_SPIN(xb_ld(&bar[XB_XGEN(b.x)]) == gen, bar);
            __builtin_amdgcn_fence(__ATOMIC_ACQUIRE, "agent");
            asm volatile("s_waitcnt vmcnt(0)" ::: "memory");
        }
    }
    __syncthreads();
}

struct Args { const float* in[20]; float* out; unsigned char* ws; int ph_lo, ph_hi, nch, pad; };

__global__ void __launch_bounds__(512, 2) mk_fwd(Args args) {
    extern __shared__ __attribute__((aligned(16))) unsigned char lds_raw[];
    LAS unsigned char* lds = (LAS unsigned char*)lds_raw;
    cg::grid_group grid = cg::this_grid();
    const int tid = threadIdx.x, lane = tid & 63, wave = __builtin_amdgcn_readfirstlane(tid >> 6);
    const int G = gridDim.x, bx = blockIdx.x;
    const int vcu = (G % 8 == 0) ? (bx % 8) * (G / 8) + bx / 8 : bx;
    const int gw = vcu * 8 + wave, NGW = G * 8;
    unsigned char* ws = args.ws;
    const float* x_in = args.in[0]; const float* mem_in = args.in[1];
    float* X = args.out;
    float* part = (float*)(ws + WS_PART); float* partM = (float*)(ws + WS_PARTM); float* logf = (float*)(ws + WS_LOGF);
    unsigned char* dsc = (unsigned char*)args.out;
    bf16_t* memb = (bf16_t*)(dsc + DO_MEMB); bf16_t* KVm = (bf16_t*)(dsc + DO_KVM); bf16_t* WKVT = (bf16_t*)(dsc + DO_WKVT);
    bf16_t* Xb = (bf16_t*)(ws + WS_XB); bf16_t* BIG = (bf16_t*)(ws + WS_BIG);
    const int NCH = args.nch, TC = TOK / NCH, BPC = NB / NCH;
    const int lo = args.ph_lo, hi = args.ph_hi; int ph = 0;
#define PH_ON (ph >= lo && ph < hi)
#define MK_CAT2(a, b) a##b
#define MK_CAT(a, b) MK_CAT2(a, b)
#define PH_BAR() do { if (args.pad == 0x5eed) grid.sync(); else xcd_barrier(bar); } while (0)
    int dup_cnt = 0; (void)dup_cnt;
#define PH_END_PLAIN() do { if (ph >= lo && ph + 1 < hi) PH_BAR(); ++ph; } while (0)
#define PH_END_DUP() do { if (ph >= lo && ph + 1 < hi) PH_BAR(); if (dup_cnt < MK_DUPN) { ++dup_cnt; ph -= (MK_DUP_HI - MK_DUP_LO); goto MK_CAT(DUPL_, MK_DUP_LO); } ++ph; } while (0)
#define PH_BEGIN(ty) if ((ty) == MK_DUP_LO) dup_cnt = 0; MK_CAT(DUPL_, ty): if (PH_ON) {
#define PH_END(ty) MK_CAT(PH_END_, ty)()
#if MK_DUP_HI == 0
#define PH_END_0() PH_END_DUP()
#else
#define PH_END_0() PH_END_PLAIN()
#endif
#if MK_DUP_HI == 1
#define PH_END_1() PH_END_DUP()
#else
#define PH_END_1() PH_END_PLAIN()
#endif
#if MK_DUP_HI == 2
#define PH_END_2() PH_END_DUP()
#else
#define PH_END_2() PH_END_PLAIN()
#endif
#if MK_DUP_HI == 3
#define PH_END_3() PH_END_DUP()
#else
#define PH_END_3() PH_END_PLAIN()
#endif
#if MK_DUP_HI == 4
#define PH_END_4() PH_END_DUP()
#else
#define PH_END_4() PH_END_PLAIN()
#endif
#if MK_DUP_HI == 5
#define PH_END_5() PH_END_DUP()
#else
#define PH_END_5() PH_END_PLAIN()
#endif
#if MK_DUP_HI == 6
#define PH_END_6() PH_END_DUP()
#else
#define PH_END_6() PH_END_PLAIN()
#endif
#if MK_DUP_HI == 7
#define PH_END_7() PH_END_DUP()
#else
#define PH_END_7() PH_END_PLAIN()
#endif
#if MK_DUP_HI == 8
#define PH_END_8() PH_END_DUP()
#else
#define PH_END_8() PH_END_PLAIN()
#endif
#if MK_DUP_HI == 9
#define PH_END_9() PH_END_DUP()
#else
#define PH_END_9() PH_END_PLAIN()
#endif
#if MK_DUP_HI == 10
#define PH_END_10() PH_END_DUP()
#else
#define PH_END_10() PH_END_PLAIN()
#endif
#if MK_DUP_HI == 11
#define PH_END_11() PH_END_DUP()
#else
#define PH_END_11() PH_END_PLAIN()
#endif
#if MK_DUP_HI == 12
#define PH_END_12() PH_END_DUP()
#else
#define PH_END_12() PH_END_PLAIN()
#endif
    volatile LAS unsigned* MISC = (volatile LAS unsigned*)(lds + 146432);
    if (tid < 32) MISC[tid] = 0u;
    __syncthreads();
    XcdBarrier bar; bar.bar = (unsigned*)ws; bar.x = 0; bar.st = nullptr;
    if (hi - lo > 1) bar = xcd_barrier_post((unsigned*)ws, MISC + 8);

    PH_BEGIN(0)
        LAS float* scr = (LAS float*)(lds + wave * 16640);
        for (int l = 0; l < DEPTH; ++l) {
            unsigned char* wl = dsc + DO_W + (size_t)l * W_LAYER;
            bf16_t* W1T = (bf16_t*)(wl + WO_W1T);
            const float* w_in = args.in[3] + (size_t)l * DM * IN_COLS; const float* mixg = args.in[2] + l * DM;
            tr_job(w_in, IN_COLS, DM, 0, 3072, 3072, mixg, W1T, DM, 0, 0, scr, lane, gw, NGW);
            tr_job(w_in, IN_COLS, DM, 3080, 3840, 3840, mixg, W1T, DM, 3072, 0, scr, lane, gw, NGW);
            tr_job(w_in, IN_COLS, DM, 3072, 64, 8, mixg, W1T, DM, 6912, 0, scr, lane, gw, NGW);
            for (int i = gw * 64 + lane; i < 192 * DM / 8; i += NGW * 64) *(u32x4*)(W1T + (size_t)6976 * DM + (size_t)i * 8) = (u32x4){0u, 0u, 0u, 0u};
            for (int b = 0; b < 3; ++b) tr_job(args.in[7] + ((size_t)l * 3 + b) * 512 * DM, DM, 512, 0, DM, DM, nullptr, (bf16_t*)(wl + WO_WBT), 1536, 0, 512 * b, scr, lane, gw, NGW);
            tr_job(args.in[8] + (size_t)l * DM * DM, DM, DM, 0, DM, DM, nullptr, (bf16_t*)(wl + WO_WOT), DM, 0, 0, scr, lane, gw, NGW);
            tr_job(args.in[12] + (size_t)l * DM * DM, DM, DM, 0, DM, DM, args.in[10] + l * DM, (bf16_t*)(wl + WO_WXQT), DM, 0, 0, scr, lane, gw, NGW);
            tr_job(args.in[13] + (size_t)l * DM * 2048, 2048, DM, 0, 2048, 2048, args.in[11] + l * DM, WKVT, DM, 2048 * l, 0, scr, lane, gw, NGW);
            tr_job(args.in[14] + (size_t)l * DM * DM, DM, DM, 0, DM, DM, nullptr, (bf16_t*)(wl + WO_WXOT), DM, 0, 0, scr, lane, gw, NGW);
            {
                const float* wg = args.in[16] + (size_t)l * DM * DFF; const float* wu = args.in[17] + (size_t)l * DM * DFF; const float* fg = args.in[15] + l * DM;
                bf16_t* WGUT = (bf16_t*)(wl + WO_WGUT);
                for (int it = gw; it < 16 * 88; it += NGW) { const int kb = it / 88, d = it % 88, j = d >> 2, s = (d >> 1) & 1, i = d & 1;
                    tr_item(s ? wu : wg, DFF, 128 * j + 64 * i, 64, fg, WGUT, DM, 64 * d, 0, 64 * kb, scr, lane); }
            }
            tr_job(args.in[18] + (size_t)l * DFF * DM, DM, DFF, 0, DM, DM, nullptr, (bf16_t*)(wl + WO_WDT), DFF, 0, 0, scr, lane, gw, NGW);
        }
        for (int m = gw; m < TOK; m += 4 * NGW) rows_to_bf16<4>(x_in, Xb, part, m, NGW, lane);
        for (int m = gw; m < NB * MEMLEN; m += NGW) rows_to_bf16<1>(mem_in, memb, partM, m, 0, lane);
    }
    PH_END(0);
    for (int l = 0; l < DEPTH; ++l) {
        unsigned char* wl = dsc + DO_W + (size_t)l * W_LAYER;
        for (int ch = 0; ch < NCH; ++ch) {
            const int r0 = ch * TC;
            bf16_t* proj = BIG;
            PH_BEGIN(2)
                pg8::Gemm g{Xb + (size_t)r0 * DM, (const bf16_t*)(wl + WO_W1T), DM, DM, DM, 0, 0}; pg8::StaticOrder<1> S; S.init(TC, W1_ROWS, G, bx);
                prep_rstd(lds, part + (size_t)r0 * 16, S);
                EpiInProj E{proj, logf, (const LAS float*)(lds + RSTD_TAB_OFF), args.in[4] + l * 8};
                pg8::gemm_phase<EpiInProj, 1>(lds, g, S, E);
            }
            PH_END(2);
            PH_BEGIN(3)
                if (l == 0 && ch == 0 && G >= 128 && bx >= G - 64) {
                    pg8::Gemm g{memb, WKVT, DM, DM, DM, 0, 0}; pg8::StaticOrder<1> S; S.init(NB * MEMLEN, 4096, 64, bx - (G - 64));
                    prep_rstd(lds, partM, S);
                    EpiScale E{KVm, 4096, (const LAS float*)(lds + RSTD_TAB_OFF), 1.0f};
                    pg8::gemm_phase<EpiScale, 1>(lds, g, S, E);
                    __syncthreads();
                }
                for (int sb = bx; sb < BPC * 8; sb += G) {
                    const int bl = sb >> 3, h = sb & 7;
                    const float* lf = logf + (size_t)(bl * SEQ + 16 * tid) * 8 + h;
                    float v[16]; float run = 0.f;
#pragma unroll
                    for (int i = 0; i < 16; ++i) { run += lf[i * 8]; v[i] = run; }
                    float xs = run;
#pragma unroll
                    for (int d = 1; d < 64; d <<= 1) { const float y = __shfl_up(xs, d); if (lane >= d) xs += y; }
                    LAS float* wsum = (LAS float*)lds;
                    __syncthreads();
                    if (lane == 63) wsum[wave] = xs;
                    __syncthreads();
                    float off = xs - run;
                    for (int w = 0; w < wave; ++w) off += wsum[w];
                    u32x4* co = (u32x4*)(ws + WS_KX) + (size_t)sb * SEQ + 16 * tid;
#pragma unroll
                    for (int i = 0; i < 16; ++i) {
                        const float nv = -(off + v[i]) * LOG2E;
                        const unsigned a = cvt_pk_bf16(nv, 0.f) & 0xffffu; const float r1 = nv - __uint_as_float(a << 16);
                        const unsigned b = cvt_pk_bf16(r1, 0.f) & 0xffffu; const float r2 = r1 - __uint_as_float(b << 16);
                        const unsigned c = cvt_pk_bf16(r2, 0.f) & 0xffffu;
                        co[i] = (u32x4){a | (b << 16), c | 0x3f800000u, 0x3f803f80u, 0u};
                    }
                    __syncthreads();
                }
                {
                    const float* cw = args.in[5] + (size_t)l * 3 * 512;
                    const int nsb = (G > 2 * BPC * 8) ? BPC * 8 : 0;
                    for (int item = (bx - nsb) * 512 + tid; bx >= nsb && item < (TC / 8) * 64; item += (G - nsb) * 512) {
                        const int cgp = item & 63, t0 = (item >> 6) * 8, c0 = cgp * 8;
                        float w0[8], w1[8], w2[8], z1[8], z2[8];
#pragma unroll
                        for (int j = 0; j < 8; ++j) { w0[j] = cw[c0 + j]; w1[j] = cw[512 + c0 + j]; w2[j] = cw[1024 + c0 + j]; z1[j] = 0.f; z2[j] = 0.f; }
                        if ((t0 % SEQ) != 0) {
                            const bf16_t* p2 = proj + (size_t)(t0 - 2) * PROJ_LD + c0; const bf16_t* p1 = proj + (size_t)(t0 - 1) * PROJ_LD + c0;
                            const u32x4 c2 = *(const u32x4*)(p2 + PC_C), u2 = *(const u32x4*)(p2 + PC_U), c1 = *(const u32x4*)(p1 + PC_C), u1 = *(const u32x4*)(p1 + PC_U);
#pragma unroll
                            for (int j = 0; j < 4; ++j) { z2[2 * j] = bf_lo(c2[j]) * bf_lo(u2[j]); z2[2 * j + 1] = bf_hi(c2[j]) * bf_hi(u2[j]); z1[2 * j] = bf_lo(c1[j]) * bf_lo(u1[j]); z1[2 * j + 1] = bf_hi(c1[j]) * bf_hi(u1[j]); }
                        }
                        u32x4 yo[8];
#pragma unroll
                        for (int i = 0; i < 8; ++i) {
                            bf16_t* p = proj + (size_t)(t0 + i) * PROJ_LD + c0;
                            const u32x4 cc = *(const u32x4*)(p + PC_C), uu = *(const u32x4*)(p + PC_U), bb = *(const u32x4*)(p + PC_B);
                            float z0[8], y[8];
#pragma unroll
                            for (int j = 0; j < 4; ++j) { z0[2 * j] = bf_lo(cc[j]) * bf_lo(uu[j]); z0[2 * j + 1] = bf_hi(cc[j]) * bf_hi(uu[j]); }
#pragma unroll
                            for (int j = 0; j < 4; ++j) { y[2 * j] = bf_lo(bb[j]) * (w0[2 * j] * z2[2 * j] + w1[2 * j] * z1[2 * j] + w2[2 * j] * z0[2 * j]);
                                y[2 * j + 1] = bf_hi(bb[j]) * (w0[2 * j + 1] * z2[2 * j + 1] + w1[2 * j + 1] * z1[2 * j + 1] + w2[2 * j + 1] * z0[2 * j + 1]); }
                            u32x4 o; o.x = cvt_pk_bf16(y[0], y[1]); o.y = cvt_pk_bf16(y[2], y[3]); o.z = cvt_pk_bf16(y[4], y[5]); o.w = cvt_pk_bf16(y[6], y[7]);
                            yo[i] = o;
#pragma unroll
                            for (int j = 0; j < 8; ++j) { z2[j] = z1[j]; z1[j] = z0[j]; }
                        }
#pragma unroll
                        for (int i = 0; i < 8; ++i) *(u32x4*)(proj + (size_t)(t0 + i) * PROJ_LD + c0 + PC_B) = yo[i];
                    }
                }
                {
                    int t4 = threadIdx.x; asm volatile("" : "+v"(t4));
                    const int ln = t4 & 63, hd = ln >> 3, sub = ln & 7;
                    unsigned* tq = (unsigned*)(ws + 32768) + (l * NCH + ch) * 1088;
                    for (int rb = vcu * 8 + (t4 >> 6); rb < TC / 16; rb += NGW) {
                        float mq = 0.f, mk = 0.f, md = -INFINITY;
#pragma unroll 4
                        for (int i = 0; i < 16; ++i) {
                            const bf16_t* p = proj + (size_t)(rb * 16 + i) * PROJ_LD + hd * 64 + sub * 8;
                            const u32x4 qv = *(const u32x4*)(p + PC_FQ), kv = *(const u32x4*)(p + PC_FK);
                            float qq = 0.f, kk = 0.f, qk = 0.f;
#pragma unroll
                            for (int j = 0; j < 4; ++j) { const float q0 = bf_lo(qv[j]), q1 = bf_hi(qv[j]), k0 = bf_lo(kv[j]), k1 = bf_hi(kv[j]); qq += q0 * q0 + q1 * q1; kk += k0 * k0 + k1 * k1; qk += q0 * k0 + q1 * k1; }
#pragma unroll
                            for (int o = 1; o < 8; o <<= 1) { qq += __shfl_xor(qq, o); kk += __shfl_xor(kk, o); qk += __shfl_xor(qk, o); }
                            mq = fmaxf(mq, qq); mk = fmaxf(mk, kk); md = fmaxf(md, -qk);
                        }
                        if (sub == 0) {
                            const int row0 = rb * 16, bh = (row0 / SEQ) * 8 + hd, qb = (row0 % SEQ) >> 8;
                            const unsigned db = __float_as_uint(md), dkey = (db & 0x80000000u) ? ~db : (db | 0x80000000u);
                            atomicMax(tq + bh, __float_as_uint(mq)); atomicMax(tq + 32 + bh, __float_as_uint(mk)); atomicMax(tq + 64 + bh * 32 + qb, dkey);
                        }
                    }
                }
                __syncthreads();
                {
                    LAS float* bt8 = (LAS float*)(lds + 6 * (64 * 144 + 64 * 160));
                    int t3 = threadIdx.x; asm volatile("" : "+v"(t3));
                    for (int idx = t3; idx < 1024; idx += 512) bt8[idx] = args.in[9][(int)T5_BUCKET[idx & 127] * 8 + (idx >> 7)] * LOG2E;
                }
                __syncthreads();
                for (int un = vcu; un < BPC * 8 * 32; un += G) {
                    const int qb = un & 31, hq = (un >> 5) & 7, bl = un >> 8, kvh = hq >> 2;
                    const bf16_t* base = proj + (size_t)bl * SEQ * PROJ_LD;
                    const int q0 = qb * 256; const int tl = q0 >= 128 ? (q0 - 128) / 64 : 0;
                    attn_unit<64, 2, 1, 6>(lds, base + (size_t)q0 * PROJ_LD + PC_SQ + hq * 64, PROJ_LD, base + PC_SK + kvh * 64, PROJ_LD, base + PC_SV + kvh * 64, PROJ_LD,
                                        proj + ((size_t)bl * SEQ + q0) * PROJ_LD + PC_SQ + hq * 64, PROJ_LD, q0, tl, (q0 + 256) / 64, hq, args.in[6][l * 8 + hq] * LOG2E);
                }
            }
            PH_END(3);
            PH_BEGIN(4)
                const int inst = l * NCH + ch, nbh = BPC * 8, nun = nbh * 32;
                unsigned* qctr = (unsigned*)(ws + 20480) + 64 * inst;
                const unsigned* tq = (const unsigned*)(ws + 32768) + inst * 1088;
                volatile LAS int* sh = (volatile LAS int*)(lds + 146944);
                for (;;) {
                    __syncthreads();
                    if (wave == 0) {
                        int u = 0; if (lane == 0) u = (int)atomicAdd(qctr, 1u);
                        u = __builtin_amdgcn_readfirstlane(u);
                        int t0 = 0;
                        if (u < nun) {
                            const int qb = 31 - u / nbh, bh = u % nbh, NT = 4 * qb + 4;
                            const u32x4* kx = (const u32x4*)(ws + WS_KX) + (size_t)bh * SEQ;
                            const float qk = sqrtf(__uint_as_float(tq[bh]) * __uint_as_float(tq[32 + bh])) * 1.0001f;
                            const unsigned dkey = tq[64 + bh * 32 + qb]; const float dmin = -__uint_as_float((dkey & 0x80000000u) ? (dkey & 0x7fffffffu) : ~dkey);
                            const u32x4 w0 = kx[qb * 256]; const float nk0 = bf_lo(w0.x) + bf_hi(w0.x) + bf_lo(w0.y);
                            const bool valid = (2 * lane + 2 <= NT - 4);
                            float nkp = 0.f; if (valid) { const u32x4 w = kx[128 * lane + 127]; nkp = bf_lo(w.x) + bf_hi(w.x) + bf_lo(w.y); }
                            const bool skip = valid && (nkp - nk0 + qk - dmin <= -32.0f);
                            const unsigned long long mk = __ballot(skip);
                            const int np = (~mk == 0ull) ? 64 : (__ffsll((long long)~mk) - 1);
                            t0 = 2 * np;
                        }
                        if (lane == 0) { sh[0] = u; sh[1] = t0; }
                    }
                    __syncthreads();
                    const int u = sh[0], t0 = sh[1];
                    if (u >= nun) break;
                    const int qb = 31 - u / nbh, bh = u % nbh;
                    fox::attn_unit<32>(bh >> 3, bh & 7, qb, (const fox::bf16*)(proj + PC_FQ), (const fox::bf16*)(proj + PC_FK), (const fox::bf16*)(proj + PC_FV),
                                      (const fox::bf16*)(ws + WS_KX) + (size_t)bh * SEQ * 8, (fox::bf16*)(proj + PC_FQ), (char*)lds_raw, t0);
                }
            }
            PH_END(4);
            PH_BEGIN(5)
                pg8::Gemm g{proj, (const bf16_t*)(wl + WO_WBT), PROJ_LD, 1536, 512, 1536, 512}; pg8::StaticOrder<3> S; S.init(TC, DM, G, bx);
                EpiMerge E{proj, NCH == 1 ? proj + PC_G : (bf16_t*)(ws + WS_MERGED2) + (size_t)r0 * DM, NCH == 1 ? PROJ_LD : DM};
                pg8::gemm_phase<EpiMerge, 3>(lds, g, S, E);
            }
            PH_END(5);
        }
        PH_BEGIN(6)
            pg8::Gemm g{NCH == 1 ? BIG + PC_G : (const bf16_t*)(ws + WS_MERGED2), (const bf16_t*)(wl + WO_WOT), NCH == 1 ? PROJ_LD : DM, DM, DM, 0, 0}; pg8::StaticOrder<1> S; S.init(TOK, DM, G, bx);
            EpiResid E{l == 0 ? x_in : nullptr, Xb, part};
            pg8::gemm_phase<EpiResid, 1>(lds, g, S, E);
        }
        PH_END(6);
        bf16_t* Qx = BIG;
        PH_BEGIN(7)
            pg8::Gemm g{Xb, (const bf16_t*)(wl + WO_WXQT), DM, DM, DM, 0, 0}; pg8::StaticOrder<1> S; S.init(TOK, DM, G, bx);
            prep_rstd(lds, part, S);
            EpiScale E{Qx, DM, (const LAS float*)(lds + RSTD_TAB_OFF), C2_256};
            pg8::gemm_phase<EpiScale, 1>(lds, g, S, E);
        }
        PH_END(7);
        PH_BEGIN(8)
            for (int un = vcu; un < NB * 4 * 64; un += G) {
                const int qb = un & 63, h = (un >> 6) & 3, b = un >> 8;
                const bf16_t* kv = KVm + (size_t)b * MEMLEN * 4096 + l * 2048 + h * 256;
                bf16_t* q = Qx + ((size_t)b * SEQ + qb * 128) * DM + h * 256;
                attn_unit<256, 1, 2, 1>(lds, q, DM, kv, 4096, kv + 1024, 4096, q, DM, 0, 0, 4, 0, 0.f);
            }
        }
        PH_END(8);
        PH_BEGIN(9)
            pg8::Gemm g{Qx, (const bf16_t*)(wl + WO_WXOT), DM, DM, DM, 0, 0}; pg8::StaticOrder<1> S; S.init(TOK, DM, G, bx);
            EpiResid E{nullptr, Xb, part};
            pg8::gemm_phase<EpiResid, 1>(lds, g, S, E);
        }
        PH_END(9);
        bf16_t* Hb = BIG;
        PH_BEGIN(10)
            pg8::Gemm g{Xb, (const bf16_t*)(wl + WO_WGUT), DM, DM, DM, 0, 0}; pg8::StaticOrder<1> S; S.init(TOK, 2 * DFF, G, bx);
            prep_rstd(lds, part, S);
            EpiSwiglu E{Hb, (const LAS float*)(lds + RSTD_TAB_OFF)};
            pg8::gemm_phase<EpiSwiglu, 1>(lds, g, S, E);
        }
        PH_END(10);
        PH_BEGIN(11)
            pg8::Gemm g{Hb, (const bf16_t*)(wl + WO_WDT), DFF, DFF, DFF, 0, 0}; pg8::StaticOrder<1> S; S.init(TOK, DM, G, bx);
            EpiResid E{nullptr, Xb, part};
            pg8::gemm_phase<EpiResid, 1>(lds, g, S, E);
        }
        PH_END(11);
    }
    PH_BEGIN(12)
        const float* fg = args.in[19];
        int t2 = threadIdx.x; asm volatile("" : "+v"(t2));
        const int lane = t2 & 63, gw = vcu * 8 + (t2 >> 6);
        for (int m0 = gw; m0 < TOK; m0 += 4 * NGW) {
            u32x2 w[4][4];
#pragma unroll
            for (int r = 0; r < 4; ++r) { const u32x2* xr = (const u32x2*)(Xb + (size_t)(m0 + r * NGW) * DM) + lane;
#pragma unroll
                for (int j = 0; j < 4; ++j) w[r][j] = xr[64 * j]; }
#pragma unroll
            for (int r = 0; r < 4; ++r) {
                f32x4* orow = (f32x4*)(X + (size_t)(m0 + r * NGW) * DM) + lane; f32x4 v[4]; float s = 0.f;
#pragma unroll
                for (int j = 0; j < 4; ++j) { v[j] = (f32x4){bf_lo(w[r][j].x), bf_hi(w[r][j].x), bf_lo(w[r][j].y), bf_hi(w[r][j].y)}; s += (v[j][0] * v[j][0] + v[j][1] * v[j][1]) + (v[j][2] * v[j][2] + v[j][3] * v[j][3]); }
                const float rstd = 1.0f / sqrtf(wave_sum(s) * (1.0f / DM) + RMS_EPS);
#pragma unroll
                for (int j = 0; j < 4; ++j) { const f32x4 gg = *((const f32x4*)fg + lane + 64 * j); orow[64 * j] = v[j] * rstd * gg; }
            }
        }
    }
    PH_END(12);
#undef PH_ON
#undef PH_END
#undef PH_BEGIN
}

extern "C" void kernel_launch(void* const* d_in, const int* in_sizes, int n_in, void* d_out, int out_size, void* d_ws, size_t ws_size, hipStream_t stream) {
    static int grid = 0;
    if (grid == 0) {
        int dev = 0, cus = 0;
        if (n_in != 20 || out_size != TOK * DM || ws_size < WS_NEED2) { fprintf(stderr, "kernel_launch: unexpected problem (n_in %d out %d ws %zu)\n", n_in, out_size, ws_size); grid = -1; return; }
        hipGetDevice(&dev); hipDeviceGetAttribute(&cus, hipDeviceAttributeMultiprocessorCount, dev);
        if (hipFuncSetAttribute((const void*)mk_fwd, hipFuncAttributeMaxDynamicSharedMemorySize, LDS_BYTES) != hipSuccess) { fprintf(stderr, "kernel_launch: hipFuncSetAttribute failed\n"); grid = -1; return; }
        int per_cu = 0;
        hipOccupancyMaxActiveBlocksPerMultiprocessor(&per_cu, (const void*)mk_fwd, 512, LDS_BYTES);
        (void)hipGetLastError();
        fprintf(stderr, "kernel_launch: cus %d per_cu %d ws %zu\n", cus, per_cu, ws_size);
        grid = cus;
    }
    if (grid < 0) return;
    if (hipMemsetAsync(d_ws, 0, 32768, stream) != hipSuccess) { fprintf(stderr, "kernel_launch: memset failed\n"); return; }
    Args a{};
    for (int i = 0; i < 20; ++i) a.in[i] = (const float*)d_in[i];
    a.out = (float*)d_out; a.ws = (unsigned char*)d_ws; a.nch = (ws_size >= WS_NEED1) ? 1 : 2; a.pad = 0;
    const int nph = 1 + DEPTH * (a.nch * 4 + 6) + 1;
#if MK_SINGLE
    a.ph_lo = 0; a.ph_hi = nph;
    void* kargs[] = {&a};
    hipError_t e = hipLaunchCooperativeKernel((const void*)mk_fwd, dim3(grid), dim3(512), kargs, LDS_BYTES, stream);
    if (e != hipSuccess) fprintf(stderr, "cooperative launch failed: %s\n", hipGetErrorString(e));
#else
    for (int p = 0; p < nph; ++p) { a.ph_lo = p; a.ph_hi = p + 1; hipLaunchKernelGGL(mk_fwd, dim3(grid), dim3(512), LDS_BYTES, stream, a); }
#endif
}
```

```cpp
#include <hip/hip_runtime.h>
#include <hip/hip_cooperative_groups.h>
#include <cstdio>
#include <cstdint>
#include <hip/hip_bf16.h>
#include <cmath>
namespace cg = cooperative_groups;

#ifndef MK_DUP_LO
#define MK_DUP_LO -1
#define MK_DUP_HI -1
#define MK_DUPN 0
#endif
#ifndef MK_SINGLE
#define MK_SINGLE 1
#endif

#define LAS __attribute__((address_space(3)))
typedef unsigned short bf16_t;
typedef short bf16x8 __attribute__((ext_vector_type(8)));
typedef float f32x4 __attribute__((ext_vector_type(4)));
typedef unsigned u32x4 __attribute__((ext_vector_type(4)));
typedef unsigned u32x2 __attribute__((ext_vector_type(2)));
typedef short v4i16_t __attribute__((ext_vector_type(4)));

constexpr int DM = 1024, NB = 4, SEQ = 8192, TOK = NB * SEQ, DEPTH = 2;
constexpr int PROJ_LD = 6912, W1_ROWS = 7168, IN_COLS = 6920, DFF = 2816, MEMLEN = 256;
constexpr float LOG2E = 1.4426950408889634f;
constexpr float C2_64 = 0.125f * LOG2E;
constexpr float C2_256 = 0.0625f * LOG2E;
constexpr float RMS_EPS = 1e-6f;
constexpr int PC_B = 0, PC_C = 512, PC_U = 1024, PC_FQ = 1536, PC_FK = 2048, PC_FV = 2560, PC_SQ = 3072, PC_SK = 3584, PC_SV = 3712, PC_G = 3840;

constexpr size_t MiB = 1u << 20;
constexpr size_t WS_PART = 1 * MiB, WS_PARTM = 3 * MiB, WS_LOGF = 4 * MiB, WS_KX = 5 * MiB, WS_XB = 12 * MiB, WS_BIG = 76 * MiB;
constexpr size_t DO_W = 0, W_LAYER = 40 * MiB, DO_WKVT = 80 * MiB, DO_KVM = 88 * MiB, DO_MEMB = 96 * MiB;
constexpr size_t DO_QKF0 = 98 * MiB, DO_VWF0 = 106 * MiB, DO_QKF1 = 114 * MiB, DO_VWF1 = DO_WKVT;
constexpr size_t WO_W1T = 0, WO_WBT = 14 * MiB, WO_WOT = 17 * MiB, WO_WXQT = 19 * MiB, WO_WXOT = 21 * MiB, WO_WGUT = 23 * MiB, WO_WDT = 34 * MiB;
constexpr size_t BIG_MIN = (size_t)TOK * (DM + DFF) * 2;
constexpr size_t WS_MERGED2 = WS_BIG + BIG_MIN;
constexpr size_t WS_NEED2 = WS_MERGED2 + (size_t)TOK * DM * 2, WS_NEED1 = WS_BIG + (size_t)TOK * PROJ_LD * 2;

constexpr int LDS_BYTES = 147456;

__device__ __forceinline__ unsigned cvt_pk_bf16(float lo, float hi) { unsigned r; asm("v_cvt_pk_bf16_f32 %0, %1, %2" : "=v"(r) : "v"(lo), "v"(hi)); return r; }
__device__ __forceinline__ float bf_lo(unsigned w) { return __uint_as_float(w << 16); }
__device__ __forceinline__ float bf_hi(unsigned w) { return __uint_as_float(w & 0xffff0000u); }
__device__ __forceinline__ float fast_sigmoid(float v) { return __builtin_amdgcn_rcpf(1.0f + __builtin_amdgcn_exp2f(-v * LOG2E)); }

namespace pg8 {
constexpr int BM = 256, BK = 64, HALF = 128, HTB = HALF * BK * 2, STAGE_BYTES = 8 * HTB, NXCD = 8, WGM = 8;
__host__ __device__ __forceinline__ int lds_byte(int r, int c) { const int st = (r >> 4) * 2 + (c >> 5), rr = r & 15, cc = c & 31, ob = rr * 64 + cc * 2; return st * 1024 + (ob ^ (((ob >> 9) & 1) << 5)); }
__host__ __device__ __forceinline__ void stage_rc(int b, int& R, int& C) { const int st = b / 1024, sb = b % 1024, swz = sb ^ (((sb >> 9) & 1) << 5); R = (st >> 1) * 16 + swz / 64; C = (st & 1) * 32 + (swz % 64) / 2; }
__host__ __device__ __forceinline__ int perm32(int rho) { const int n = rho >> 4, i = rho & 15; return 8 * (i >> 2) + 4 * n + (i & 3); }

struct Unit { int pm, pn, seg, idx; };
struct Gemm { const bf16_t* A; const bf16_t* Bt; int lda, ldb, K, sas, sbs; int bsB = 0, ppb = 1;
    __device__ __forceinline__ size_t sbat(int pm) const { return bsB ? (size_t)(pm / ppb) * (size_t)bsB * 2 : (size_t)0; }

    __device__ __forceinline__ int sa(int s) const { return s * sas; } __device__ __forceinline__ int sb(int s) const { return s * sbs; } };

template <int NSEG> struct StaticOrder {
    int nM, nN, nwg, G, c;
    __device__ void init(int M, int N, int G_, int c_) { nM = M / BM; nN = N / BM; nwg = nM * nN; G = G_; c = c_; }
    __device__ bool next(int i, Unit& u) const {
        const int ui = i / NSEG; u.seg = i - ui * NSEG; u.idx = ui;
        const long L = (long)ui * G + c; if (L >= nwg) return false;
        int wgid = (int)L; { const int q = nwg / NXCD, r = nwg % NXCD, xcd = wgid % NXCD, off = wgid / NXCD; wgid = (xcd < r ? xcd * (q + 1) : r * (q + 1) + (xcd - r) * q) + off; }
        const int nig = WGM * nN, gid = wgid / nig, fm = gid * WGM, gsz = (nM - fm) < WGM ? (nM - fm) : WGM;
        u.pm = fm + ((wgid % nig) % gsz); u.pn = (wgid % nig) / gsz; return true;
    }
};

template <class Epi, int NSEG>
__device__ __forceinline__ void gemm_phase(LAS unsigned char* lds, const Gemm g, const StaticOrder<NSEG>& S, const Epi& E) {
    int tid_ = threadIdx.x; asm volatile("" : "+v"(tid_));
    const int tid = tid_, wid = __builtin_amdgcn_readfirstlane(tid >> 6), lane = tid & 63, wr = wid >> 2, wc = wid & 3, fr = lane & 15, fq = lane >> 4;
    const int K = g.K, nt = K / BK;
    unsigned voffA[2], voffB[2];
#pragma unroll
    for (int i = 0; i < 2; ++i) { int R, C; stage_rc(tid * 16 + i * 8192, R, C); const int Rb = (R & ~31) + perm32(R & 31);
        voffA[i] = (unsigned)(R * g.lda + C) * 2u; voffB[i] = (unsigned)(Rb * g.ldb + C) * 2u; }
    const size_t kstep = (size_t)(BK * 2);
    const size_t hstepA = (size_t)HALF * g.lda * 2, hstepB = (size_t)HALF * g.ldb * 2;
    const size_t tstepA = 2 * hstepA, tstepB = 2 * hstepB;
    const unsigned ldsw = (unsigned)wid * 1024u;
    const int aoff = lds_byte(wr * 64 + fr, fq * 8), boff = lds_byte(wc * 32 + fr, fq * 8);
#define PG8_SA(b, h) (((b) * 2 + (h)) * HTB)
#define PG8_SB(b, h) ((4 + (b) * 2 + (h)) * HTB)
#define PG8_STAGE(bufoff, gbase, voff) do { _Pragma("unroll") for (int _i = 0; _i < 2; ++_i) \
        __builtin_amdgcn_global_load_lds((const unsigned*)((const char*)(gbase) + (voff)[_i]), (LAS unsigned*)(lds + (bufoff) + ldsw + _i * 8192), 16, 0, 0); } while (0)
#define PG8_LDA(dst, b, h) do { _Pragma("unroll") for (int m = 0; m < 4; ++m) _Pragma("unroll") for (int k = 0; k < 2; ++k) dst[m][k] = *(const LAS bf16x8*)(lds + PG8_SA(b, h) + aoff + m * 2048 + k * 1024); } while (0)
#define PG8_LDB(dst, b, h) do { _Pragma("unroll") for (int n = 0; n < 2; ++n) _Pragma("unroll") for (int k = 0; k < 2; ++k) dst[n][k] = *(const LAS bf16x8*)(lds + PG8_SB(b, h) + boff + n * 2048 + k * 1024); } while (0)
#define PG8_MMA(ai, bj, At, Bt) do { __builtin_amdgcn_s_setprio(1); _Pragma("unroll") for (int m = 0; m < 4; ++m) _Pragma("unroll") for (int n = 0; n < 2; ++n) _Pragma("unroll") for (int k = 0; k < 2; ++k) \
        acc[ai][bj][m][n] = __builtin_amdgcn_mfma_f32_16x16x32_bf16(Bt[n][k], At[m][k], acc[ai][bj][m][n], 0, 0, 0); __builtin_amdgcn_s_setprio(0); } while (0)
#define PG8_WAIT_V(n) asm volatile("s_waitcnt vmcnt(" #n ")" ::: "memory")
#define PG8_WAIT_L(n) asm volatile("s_waitcnt lgkmcnt(" #n ")" ::: "memory")
#define PG8_BAR __builtin_amdgcn_s_barrier()
#define PG8_SCHED __builtin_amdgcn_sched_barrier(0)
    Unit cur, nxt; int ui = 0;
    if (!S.next(0, cur)) return;
    f32x4 acc[2][2][4][2];
#pragma unroll
    for (int a = 0; a < 2; ++a)
#pragma unroll
        for (int b = 0; b < 2; ++b)
#pragma unroll
            for (int m = 0; m < 4; ++m)
#pragma unroll
                for (int n = 0; n < 2; ++n) acc[a][b][m][n] = (f32x4){0.f, 0.f, 0.f, 0.f};
    bf16x8 At[4][2], B0[2][2], B1[2][2];
    const char* cA = (const char*)g.A + (size_t)cur.pm * tstepA + (size_t)g.sa(cur.seg) * 2; const char* cB = (const char*)g.Bt + g.sbat(cur.pm) + (size_t)cur.pn * tstepB + (size_t)g.sb(cur.seg) * 2;
    PG8_STAGE(PG8_SB(0, 0), cB, voffB); PG8_STAGE(PG8_SB(0, 1), cB + hstepB, voffB); PG8_STAGE(PG8_SA(0, 0), cA, voffA); PG8_STAGE(PG8_SA(0, 1), cA + hstepA, voffA);
    if (wr == 1) PG8_BAR;
    PG8_WAIT_V(2); PG8_BAR;
    PG8_STAGE(PG8_SB(1, 0), cB + kstep, voffB); PG8_STAGE(PG8_SA(1, 0), cA + kstep, voffA); PG8_STAGE(PG8_SB(1, 1), cB + hstepB + kstep, voffB);
    PG8_WAIT_V(6); PG8_BAR;
    for (;;) {
        const bool has_next = S.next(ui + 1, nxt);
        const char* nA = has_next ? (const char*)g.A + (size_t)nxt.pm * tstepA + (size_t)g.sa(nxt.seg) * 2 : cA;
        const char* nB = has_next ? (const char*)g.Bt + g.sbat(nxt.pm) + (size_t)nxt.pn * tstepB + (size_t)g.sb(nxt.seg) * 2 : cB;
        for (int t = 0; t < nt; t += 2) {
            const bool last = (t == nt - 2);
            const char* a1 = cA + (size_t)(t + 1) * kstep;
            const char* a2 = last ? nA : cA + (size_t)(t + 2) * kstep; const char* b2 = last ? nB : cB + (size_t)(t + 2) * kstep;
            const char* a3 = a2 + kstep; const char* b3 = b2 + kstep;
            PG8_LDB(B0, 0, 0); PG8_LDB(B1, 0, 1); PG8_SCHED; PG8_LDA(At, 0, 0); PG8_STAGE(PG8_SA(1, 1), a1 + hstepA, voffA);
            PG8_WAIT_V(8); PG8_WAIT_L(0); PG8_BAR; PG8_MMA(0, 0, At, B0); PG8_MMA(0, 1, At, B1); PG8_BAR; PG8_SCHED;
            PG8_LDA(At, 0, 1); PG8_STAGE(PG8_SB(0, 0), b2, voffB); PG8_STAGE(PG8_SB(0, 1), b2 + hstepB, voffB); PG8_STAGE(PG8_SA(0, 0), a2, voffA);
            PG8_WAIT_V(8); PG8_WAIT_L(0); PG8_BAR; PG8_MMA(1, 0, At, B0); PG8_MMA(1, 1, At, B1); PG8_BAR; PG8_SCHED;
            PG8_LDB(B0, 1, 0); PG8_LDB(B1, 1, 1); PG8_SCHED; PG8_LDA(At, 1, 0); PG8_STAGE(PG8_SA(0, 1), a2 + hstepA, voffA);
            PG8_WAIT_V(8); PG8_WAIT_L(0); PG8_BAR; PG8_MMA(0, 0, At, B0); PG8_MMA(0, 1, At, B1); PG8_BAR; PG8_SCHED;
            PG8_LDA(At, 1, 1); PG8_STAGE(PG8_SB(1, 0), b3, voffB); PG8_STAGE(PG8_SB(1, 1), b3 + hstepB, voffB); PG8_STAGE(PG8_SA(1, 0), a3, voffA);
            PG8_WAIT_V(8); PG8_WAIT_L(0); PG8_BAR; PG8_MMA(1, 0, At, B0); PG8_MMA(1, 1, At, B1); PG8_BAR; PG8_SCHED;
        }
        if (wr == 0) PG8_BAR;
        E(acc, cur, wr, wc, fr, fq);
        if (!has_next) break;
        if (NSEG == 1 || cur.seg == NSEG - 1) {
#pragma unroll
            for (int a = 0; a < 2; ++a)
#pragma unroll
                for (int b = 0; b < 2; ++b)
#pragma unroll
                    for (int m = 0; m < 4; ++m)
#pragma unroll
                        for (int n = 0; n < 2; ++n) acc[a][b][m][n] = (f32x4){0.f, 0.f, 0.f, 0.f};
        }
        cur = nxt; cA = nA; cB = nB; ++ui;
        if (wr == 1) PG8_BAR;
    }
    PG8_WAIT_V(0);
    PG8_BAR;
#undef PG8_SA
#undef PG8_SB
#undef PG8_STAGE
#undef PG8_LDA
#undef PG8_LDB
#undef PG8_MMA
#undef PG8_WAIT_V
#undef PG8_WAIT_L
#undef PG8_BAR
#undef PG8_SCHED
}
}

typedef f32x4 Acc[2][2][4][2];

constexpr int RSTD_TAB_OFF = 131072, RSTD_TAB_UNITS = 15;
template <class Sched> __device__ __forceinline__ void prep_rstd(LAS unsigned char* lds, const float* part, const Sched& S) {
    LAS float* tab = (LAS float*)(lds + RSTD_TAB_OFF); pg8::Unit u;
    int t_ = threadIdx.x; asm volatile("" : "+v"(t_));
    const int r = t_ & 255;
    for (int i = t_ >> 8; i < RSTD_TAB_UNITS && S.next(i, u); i += 2) {
        const f32x4* p = (const f32x4*)(part + (size_t)(u.pm * 256 + r) * 16);
        const f32x4 a = p[0], b = p[1], c = p[2], d = p[3];
        const float sm = ((a[0] + a[1]) + (a[2] + a[3])) + ((b[0] + b[1]) + (b[2] + b[3])) + ((c[0] + c[1]) + (c[2] + c[3])) + ((d[0] + d[1]) + (d[2] + d[3]));
        tab[i * 256 + r] = 1.0f / sqrtf(sm * (1.0f / DM) + RMS_EPS);
    }
    __syncthreads();
}
__device__ __forceinline__ void row_rstd(const LAS float* tab, const pg8::Unit& u, int wr, int fr, float (&rs)[2][4]) {
#pragma unroll
    for (int ai = 0; ai < 2; ++ai)
#pragma unroll
        for (int m = 0; m < 4; ++m) rs[ai][m] = tab[u.idx * 256 + ai * 128 + wr * 64 + m * 16 + fr];
}
__device__ __forceinline__ u32x4 pack8(const f32x4 a, const f32x4 b) { u32x4 w; w.x = cvt_pk_bf16(a[0], a[1]); w.y = cvt_pk_bf16(a[2], a[3]); w.z = cvt_pk_bf16(b[0], b[1]); w.w = cvt_pk_bf16(b[2], b[3]); return w; }

struct EpiInProj {
    bf16_t* proj; float* logf; const LAS float* tab; const float* fbias;
    __device__ __forceinline__ void operator()(Acc& acc, const pg8::Unit& u, int wr, int wc, int fr, int fq) const {
        const int row0 = u.pm * 256 + wr * 64 + fr;
        float rs[2][4]; row_rstd(tab, u, wr, fr, rs);
        if (u.pn == 27) {
            if (wc == 0 && fq == 0) {
                const f32x4 b0 = *(const f32x4*)(fbias), b1 = *(const f32x4*)(fbias + 4);
#pragma unroll
                for (int ai = 0; ai < 2; ++ai)
#pragma unroll
                    for (int m = 0; m < 4; ++m) {
                        f32x4 v0 = acc[ai][0][m][0] * rs[ai][m] + b0, v1 = acc[ai][0][m][1] * rs[ai][m] + b1;
#pragma unroll
                        for (int j = 0; j < 4; ++j) { v0[j] = v0[j] >= 0.f ? -log1pf(expf(-v0[j])) : v0[j] - log1pf(expf(v0[j])); v1[j] = v1[j] >= 0.f ? -log1pf(expf(-v1[j])) : v1[j] - log1pf(expf(v1[j])); }
                        float* o = logf + (size_t)(row0 + ai * 128 + m * 16) * 8;
                        *(f32x4*)o = v0; *(f32x4*)(o + 4) = v1;
                    }
            }
            return;
        }
        const bool sig = u.pn >= 15;
        const float sc = (u.pn == 6 || u.pn == 7 || u.pn == 12 || u.pn == 13) ? C2_64 : 1.0f;
        const int col0 = u.pn * 256 + wc * 32 + 8 * fq;
#pragma unroll
        for (int ai = 0; ai < 2; ++ai)
#pragma unroll
            for (int m = 0; m < 4; ++m) {
                const float r = rs[ai][m] * sc;
                bf16_t* rowp = proj + (size_t)(row0 + ai * 128 + m * 16) * PROJ_LD + col0;
#pragma unroll
                for (int bj = 0; bj < 2; ++bj) {
                    f32x4 v0 = acc[ai][bj][m][0] * r, v1 = acc[ai][bj][m][1] * r;
                    if (sig) {
#pragma unroll
                        for (int j = 0; j < 4; ++j) { v0[j] = fmaxf(fast_sigmoid(v0[j]), 1e-6f); v1[j] = fmaxf(fast_sigmoid(v1[j]), 1e-6f); }
                    }
                    *(u32x4*)(rowp + bj * 128) = pack8(v0, v1);
                }
            }
    }
};
struct EpiMerge {
    const bf16_t* proj; bf16_t* merged; int ldm;
    __device__ __forceinline__ void operator()(Acc& acc, const pg8::Unit& u, int wr, int wc, int fr, int fq) const {
        const int row0 = u.pm * 256 + wr * 64 + fr, col0 = u.pn * 256 + wc * 32 + 8 * fq;
#pragma unroll
        for (int ai = 0; ai < 2; ++ai) {
            const bf16_t* gp0 = proj + (size_t)(row0 + ai * 128) * PROJ_LD + PC_G + 1024 * u.seg + col0;
            if (u.seg < 2) {
#pragma unroll
                for (int m = 0; m < 4; ++m) {
                    const bf16_t* gp = gp0 + (size_t)m * 16 * PROJ_LD;
#pragma unroll
                    for (int bj = 0; bj < 2; ++bj) {
                        const u32x4 ga = *(const u32x4*)(gp + bj * 128), gb = *(const u32x4*)(gp + 1024 + bj * 128);
                        f32x4 f0 = {bf_lo(ga.x), bf_hi(ga.x), bf_lo(ga.y), bf_hi(ga.y)}, f1 = {bf_lo(ga.z), bf_hi(ga.z), bf_lo(ga.w), bf_hi(ga.w)};
                        const f32x4 h0 = {bf_lo(gb.x), bf_hi(gb.x), bf_lo(gb.y), bf_hi(gb.y)}, h1 = {bf_lo(gb.z), bf_hi(gb.z), bf_lo(gb.w), bf_hi(gb.w)};
#pragma unroll
                        for (int j = 0; j < 4; ++j) { f0[j] *= __builtin_amdgcn_rcpf(h0[j]); f1[j] *= __builtin_amdgcn_rcpf(h1[j]); }
                        acc[ai][bj][m][0] *= f0; acc[ai][bj][m][1] *= f1;
                    }
                }
            } else {
                u32x4 g[4][2];
#pragma unroll
                for (int m = 0; m < 4; ++m)
#pragma unroll
                    for (int bj = 0; bj < 2; ++bj) g[m][bj] = *(const u32x4*)(gp0 + (size_t)m * 16 * PROJ_LD + bj * 128);
#pragma unroll
                for (int m = 0; m < 4; ++m)
#pragma unroll
                    for (int bj = 0; bj < 2; ++bj) { const u32x4 ga = g[m][bj];
                        const f32x4 f0 = {bf_lo(ga.x), bf_hi(ga.x), bf_lo(ga.y), bf_hi(ga.y)}, f1 = {bf_lo(ga.z), bf_hi(ga.z), bf_lo(ga.w), bf_hi(ga.w)};
                        *(u32x4*)(merged + (size_t)(row0 + ai * 128 + m * 16) * ldm + col0 + bj * 128) = pack8(acc[ai][bj][m][0] * f0, acc[ai][bj][m][1] * f1); }
            }
        }
    }
};
struct EpiResid {
    const float* basef; bf16_t* xb; float* part;
    __device__ __forceinline__ void operator()(Acc& acc, const pg8::Unit& u, int wr, int wc, int fr, int fq) const {
        const int row0 = u.pm * 256 + wr * 64 + fr, col0 = u.pn * 256 + wc * 32 + 8 * fq;
#pragma unroll
        for (int ai = 0; ai < 2; ++ai) {
            if (basef) {
#pragma unroll
                for (int m = 0; m < 4; ++m)
#pragma unroll
                    for (int bj = 0; bj < 2; ++bj) { const size_t off = (size_t)(row0 + ai * 128 + m * 16) * DM + col0 + bj * 128; acc[ai][bj][m][0] += *(const f32x4*)(basef + off); acc[ai][bj][m][1] += *(const f32x4*)(basef + off + 4); asm volatile("" ::: "memory"); }
            } else {
                const bf16_t* xrow = xb + (size_t)(row0 + ai * 128) * DM + col0;
#define RES_ADD(m, bj, b) do { acc[ai][bj][m][0] += (f32x4){bf_lo(b.x), bf_hi(b.x), bf_lo(b.y), bf_hi(b.y)}; acc[ai][bj][m][1] += (f32x4){bf_lo(b.z), bf_hi(b.z), bf_lo(b.w), bf_hi(b.w)}; } while (0)
                { const u32x4 p00 = *(const u32x4*)(xrow), p01 = *(const u32x4*)(xrow + 128), p10 = *(const u32x4*)(xrow + (size_t)16 * DM), p11 = *(const u32x4*)(xrow + (size_t)16 * DM + 128);
                  const u32x4 p20 = *(const u32x4*)(xrow + (size_t)32 * DM), p21 = *(const u32x4*)(xrow + (size_t)32 * DM + 128);
                  RES_ADD(0, 0, p00); RES_ADD(0, 1, p01); RES_ADD(1, 0, p10); RES_ADD(1, 1, p11); RES_ADD(2, 0, p20); RES_ADD(2, 1, p21); }
                { const u32x4 p30 = *(const u32x4*)(xrow + (size_t)48 * DM), p31 = *(const u32x4*)(xrow + (size_t)48 * DM + 128); RES_ADD(3, 0, p30); RES_ADD(3, 1, p31); }
#undef RES_ADD
            }
#pragma unroll
            for (int m = 0; m < 4; ++m) {
                const size_t row = (size_t)(row0 + ai * 128 + m * 16);
                float ss = 0.f;
#pragma unroll
                for (int bj = 0; bj < 2; ++bj) {
                    const f32x4 x0 = acc[ai][bj][m][0], x1 = acc[ai][bj][m][1];
                    *(u32x4*)(xb + (size_t)(row0 + ai * 128) * DM + col0 + (size_t)m * 16 * DM + bj * 128) = pack8(x0, x1);
                    ss += (x0[0] * x0[0] + x0[1] * x0[1]) + (x0[2] * x0[2] + x0[3] * x0[3]) + (x1[0] * x1[0] + x1[1] * x1[1]) + (x1[2] * x1[2] + x1[3] * x1[3]);
                }
                ss += __shfl_xor(ss, 16); ss += __shfl_xor(ss, 32);
                if (fq == 0) part[row * 16 + u.pn * 4 + wc] = ss;
            }
        }
    }
};
struct EpiScale {
    bf16_t* O; int ldc; const LAS float* tab; float sc;
    __device__ __forceinline__ void operator()(Acc& acc, const pg8::Unit& u, int wr, int wc, int fr, int fq) const {
        const int row0 = u.pm * 256 + wr * 64 + fr, col0 = u.pn * 256 + wc * 32 + 8 * fq;
        float rs[2][4]; row_rstd(tab, u, wr, fr, rs);
#pragma unroll
        for (int ai = 0; ai < 2; ++ai)
#pragma unroll
            for (int m = 0; m < 4; ++m) {
                const float r = rs[ai][m] * sc;
                bf16_t* rowp = O + (size_t)(row0 + ai * 128 + m * 16) * ldc + col0;
#pragma unroll
                for (int bj = 0; bj < 2; ++bj) *(u32x4*)(rowp + bj * 128) = pack8(acc[ai][bj][m][0] * r, acc[ai][bj][m][1] * r);
            }
    }
};
struct EpiSwiglu {
    bf16_t* H; const LAS float* tab;
    __device__ __forceinline__ void operator()(Acc& acc, const pg8::Unit& u, int wr, int wc, int fr, int fq) const {
        const int row0 = u.pm * 256 + wr * 64 + fr, col0 = u.pn * 128 + wc * 32 + 8 * fq;
        float rs[2][4]; row_rstd(tab, u, wr, fr, rs);
#pragma unroll
        for (int ai = 0; ai < 2; ++ai)
#pragma unroll
            for (int m = 0; m < 4; ++m) {
                const float r = rs[ai][m];
                f32x4 h0, h1;
#pragma unroll
                for (int j = 0; j < 4; ++j) {
                    const float g0 = acc[ai][0][m][0][j] * r, u0 = acc[ai][1][m][0][j] * r, g1 = acc[ai][0][m][1][j] * r, u1 = acc[ai][1][m][1][j] * r;
                    h0[j] = g0 * fast_sigmoid(g0) * u0; h1[j] = g1 * fast_sigmoid(g1) * u1;
                }
                *(u32x4*)(H + (size_t)(row0 + ai * 128 + m * 16) * DFF + col0) = pack8(h0, h1);
            }
    }
};

struct EpiFold {
    bf16_t* O; int pms, pns, off; float sc;
    __device__ __forceinline__ void operator()(Acc& acc, const pg8::Unit& u, int wr, int wc, int fr, int fq) const {
        int fr_ = fr, fq_ = fq; asm volatile("" : "+v"(fr_), "+v"(fq_));
        bf16_t* base = O + (size_t)u.pm * pms + (size_t)u.pn * pns + off + (size_t)(wr * 64 + fr_) * 1024 + wc * 32 + 8 * fq_;
#pragma unroll
        for (int ai = 0; ai < 2; ++ai)
#pragma unroll
            for (int m = 0; m < 4; ++m)
#pragma unroll
                for (int bj = 0; bj < 2; ++bj) *(u32x4*)(base + (size_t)(ai * 128 + m * 16) * 1024 + bj * 128) = pack8(acc[ai][bj][m][0] * sc, acc[ai][bj][m][1] * sc);
    }
};
struct EpiSoftmax {
    bf16_t* P; const LAS float* tab; LAS float* ex;
    __device__ __forceinline__ void operator()(Acc& acc, const pg8::Unit& u, int wr, int wc, int fr, int fq) const {
        { int a_ = fr, b_ = fq; asm volatile("" : "+v"(a_), "+v"(b_)); fr = a_; fq = b_; }
        float rs[2][4]; row_rstd(tab, u, wr, fr, rs);
#pragma unroll
        for (int ai = 0; ai < 2; ++ai)
#pragma unroll
            for (int m = 0; m < 4; ++m) {
                float mx = -INFINITY;
#pragma unroll
                for (int bj = 0; bj < 2; ++bj)
#pragma unroll
                    for (int n = 0; n < 2; ++n) { acc[ai][bj][m][n] *= rs[ai][m]; const f32x4 v = acc[ai][bj][m][n]; mx = fmaxf(mx, fmaxf(fmaxf(v[0], v[1]), fmaxf(v[2], v[3]))); }
                mx = fmaxf(mx, __shfl_xor(mx, 16)); mx = fmaxf(mx, __shfl_xor(mx, 32));
                if (fq == 0) ex[(ai * 128 + wr * 64 + m * 16 + fr) * 4 + wc] = mx;
            }
        asm volatile("s_waitcnt lgkmcnt(0)" ::: "memory"); __builtin_amdgcn_s_barrier(); asm volatile("" ::: "memory");
        float rmx[2][4];
#pragma unroll
        for (int ai = 0; ai < 2; ++ai)
#pragma unroll
            for (int m = 0; m < 4; ++m) { const f32x4 e = *(const LAS f32x4*)(ex + (ai * 128 + wr * 64 + m * 16 + fr) * 4); rmx[ai][m] = fmaxf(fmaxf(e[0], e[1]), fmaxf(e[2], e[3])); }
        asm volatile("s_waitcnt lgkmcnt(0)" ::: "memory"); __builtin_amdgcn_s_barrier(); asm volatile("" ::: "memory");
#pragma unroll
        for (int ai = 0; ai < 2; ++ai)
#pragma unroll
            for (int m = 0; m < 4; ++m) {
                float sm = 0.f;
#pragma unroll
                for (int bj = 0; bj < 2; ++bj)
#pragma unroll
                    for (int n = 0; n < 2; ++n)
#pragma unroll
                        for (int j = 0; j < 4; ++j) { const float p = __builtin_amdgcn_exp2f(acc[ai][bj][m][n][j] - rmx[ai][m]); acc[ai][bj][m][n][j] = p; sm += p; }
                sm += __shfl_xor(sm, 16); sm += __shfl_xor(sm, 32);
                if (fq == 0) ex[(ai * 128 + wr * 64 + m * 16 + fr) * 4 + wc] = sm;
            }
        asm volatile("s_waitcnt lgkmcnt(0)" ::: "memory"); __builtin_amdgcn_s_barrier(); asm volatile("" ::: "memory");
        int fr_ = fr, fq_ = fq; asm volatile("" : "+v"(fr_), "+v"(fq_));
        const int row0 = u.pm * 256 + wr * 64 + fr_, col0 = u.pn * 256 + wc * 32 + 8 * fq_;
#pragma unroll
        for (int ai = 0; ai < 2; ++ai)
#pragma unroll
            for (int m = 0; m < 4; ++m) {
                const f32x4 e = *(const LAS f32x4*)(ex + (ai * 128 + wr * 64 + m * 16 + fr) * 4);
                const float inv = 1.0f / ((e[0] + e[1]) + (e[2] + e[3]));
#pragma unroll
                for (int bj = 0; bj < 2; ++bj) *(u32x4*)(P + (size_t)(row0 + ai * 128 + m * 16) * DM + col0 + bj * 128) = pack8(acc[ai][bj][m][0] * inv, acc[ai][bj][m][1] * inv);
            }
        asm volatile("s_waitcnt lgkmcnt(0)" ::: "memory"); __builtin_amdgcn_s_barrier(); asm volatile("" ::: "memory");
    }
};

__device__ const unsigned char T5_BUCKET[128] = {0, 1, 2, 3, 4, 5, 6, 7, 8, 9, 10, 11, 12, 13, 14, 15, 16, 16, 16, 17, 17, 18, 18, 18, 19, 19, 19, 20, 20, 20, 20, 21, 21, 21, 21, 22, 22, 22, 22, 22, 23, 23, 23, 23, 23, 23, 24, 24, 24, 24, 24, 24, 25, 25, 25, 25, 25, 25, 25, 26, 26, 26, 26, 26, 26, 26, 26, 27, 27, 27, 27, 27, 27, 27, 27, 27, 27, 28, 28, 28, 28, 28, 28, 28, 28, 28, 28, 29, 29, 29, 29, 29, 29, 29, 29, 29, 29, 29, 29, 30, 30, 30, 30, 30, 30, 30, 30, 30, 30, 30, 30, 30, 30, 31, 31, 31, 31, 31, 31, 31, 31, 31, 31, 31, 31, 31, 31, 31};

__device__ __forceinline__ v4i16_t vtr(const LAS unsigned char* p) { return __builtin_amdgcn_ds_read_tr16_b64_v4i16((LAS v4i16_t*)p); }

template <int HD, int NQ, int MODE, int STG>
__device__ __forceinline__ void attn_unit(LAS unsigned char* lds, const bf16_t* Qp, int ldq, const bf16_t* Kp, int ldk, const bf16_t* Vp, int ldv, bf16_t* Op, int ldo,
                                          int q0, int t_lo, int t_hi, int bt_head, float sink2) {
    constexpr int KS = HD * 2 + 16, VS = HD * 2 + 32, NKS = HD / 32, NDB = HD / 16, CH = HD / 64, CPR = HD / 8;
    constexpr int TILE_B = 64 * KS + 64 * VS, OFF_BT = STG * TILE_B;
    int tid_ = threadIdx.x; asm volatile("" : "+v"(tid_));
    const int tid = tid_, lane = tid & 63, wid = __builtin_amdgcn_readfirstlane(tid >> 6), ql = lane & 15, kq = lane >> 4;
    const int qw = 16 * NQ * wid, qabs = q0 + qw;
    bf16x8 qf[NQ][NKS];
#pragma unroll
    for (int qb = 0; qb < NQ; ++qb)
#pragma unroll
        for (int ks = 0; ks < NKS; ++ks) qf[qb][ks] = *(const bf16x8*)(Qp + (size_t)(qw + 16 * qb + ql) * ldq + 32 * ks + 8 * kq);
    f32x4 o[NQ][NDB]; float mrun[NQ], lrun[NQ];
#pragma unroll
    for (int qb = 0; qb < NQ; ++qb) { mrun[qb] = (MODE == 1) ? sink2 : -1e30f; lrun[qb] = 0.f;
#pragma unroll
        for (int db = 0; db < NDB; ++db) o[qb][db] = (f32x4){0.f, 0.f, 0.f, 0.f}; }
    u32x4 kr[STG][CH], vr[STG][CH];
#define AT_LOAD(j, t) do { _Pragma("unroll") for (int i = 0; i < CH; ++i) { const int c = tid + 512 * i, row = c / CPR, c8 = c % CPR; \
        kr[j][i] = *(const u32x4*)(Kp + (size_t)(64 * (t) + row) * ldk + 8 * c8); vr[j][i] = *(const u32x4*)(Vp + (size_t)(64 * (t) + row) * ldv + 8 * c8); } } while (0)
#define AT_STORE(j) do { _Pragma("unroll") for (int i = 0; i < CH; ++i) { const int c = tid + 512 * i, row = c / CPR, c8 = c % CPR; \
        *(LAS u32x4*)(lds + (j) * TILE_B + row * KS + 16 * c8) = kr[j][i]; *(LAS u32x4*)(lds + (j) * TILE_B + 64 * KS + row * VS + 16 * c8) = vr[j][i]; } } while (0)
#define AT_COMPUTE(t, TB) do { \
        bool act = true; \
        if (MODE == 1) act = (64 * (t) <= qabs + 16 * NQ - 1) && (64 * (t) + 63 >= qabs - 127); \
        if (act) { \
            const LAS unsigned char* kt = lds + (TB); const LAS unsigned char* vt = kt + 64 * KS; \
            f32x4 s[NQ][4]; \
            _Pragma("unroll") for (int kb = 0; kb < 4; ++kb) \
                _Pragma("unroll") for (int ks = 0; ks < NKS; ++ks) { \
                    const bf16x8 kf = *(const LAS bf16x8*)(kt + (16 * kb + ql) * KS + 64 * ks + 16 * kq); \
                    _Pragma("unroll") for (int qb = 0; qb < NQ; ++qb) s[qb][kb] = __builtin_amdgcn_mfma_f32_16x16x32_bf16(kf, qf[qb][ks], ks == 0 ? (f32x4){0.f, 0.f, 0.f, 0.f} : s[qb][kb], 0, 0, 0); \
                } \
            if (MODE == 1) { \
                const LAS float* BT = (const LAS float*)(lds + OFF_BT) + 128 * bt_head; \
                _Pragma("unroll") for (int qb = 0; qb < NQ; ++qb) \
                    _Pragma("unroll") for (int kb = 0; kb < 4; ++kb) \
                        _Pragma("unroll") for (int r = 0; r < 4; ++r) { const int n = (qabs + 16 * qb + ql) - (64 * (t) + 16 * kb + 4 * kq + r); const bool ok = (unsigned)n < 128u; \
                            const float bv = BT[ok ? n : 0]; s[qb][kb][r] = ok ? s[qb][kb][r] + bv : -INFINITY; } \
            } \
            bf16x8 pb[NQ][2]; \
            _Pragma("unroll") for (int qb = 0; qb < NQ; ++qb) { \
                float mx = fmaxf(fmaxf(s[qb][0][0], s[qb][0][1]), fmaxf(s[qb][0][2], s[qb][0][3])); \
                _Pragma("unroll") for (int kb = 1; kb < 4; ++kb) mx = fmaxf(mx, fmaxf(fmaxf(s[qb][kb][0], s[qb][kb][1]), fmaxf(s[qb][kb][2], s[qb][kb][3]))); \
                mx = fmaxf(mx, __shfl_xor(mx, 16)); mx = fmaxf(mx, __shfl_xor(mx, 32)); \
                const float mn = fmaxf(mrun[qb], mx), al = __builtin_amdgcn_exp2f(mrun[qb] - mn); mrun[qb] = mn; \
                float ps = 0.f; \
                _Pragma("unroll") for (int kb = 0; kb < 4; ++kb) \
                    _Pragma("unroll") for (int r = 0; r < 4; ++r) { const float p = __builtin_amdgcn_exp2f(s[qb][kb][r] - mn); s[qb][kb][r] = p; ps += p; } \
                lrun[qb] = lrun[qb] * al + ps; \
                _Pragma("unroll") for (int db = 0; db < NDB; ++db) o[qb][db] *= al; \
                _Pragma("unroll") for (int s2 = 0; s2 < 2; ++s2) { const u32x4 w = pack8(s[qb][2 * s2], s[qb][2 * s2 + 1]); pb[qb][s2] = __builtin_bit_cast(bf16x8, w); } \
            } \
            _Pragma("unroll") for (int db = 0; db < NDB; ++db) \
                _Pragma("unroll") for (int s2 = 0; s2 < 2; ++s2) { \
                    const LAS unsigned char* vb = vt + (32 * s2 + 4 * kq + (ql >> 2)) * VS + (16 * db + 4 * (ql & 3)) * 2; \
                    const v4i16_t lo = vtr(vb), hi = vtr(vb + 16 * VS); \
                    const bf16x8 vf = {lo[0], lo[1], lo[2], lo[3], hi[0], hi[1], hi[2], hi[3]}; \
                    _Pragma("unroll") for (int qb = 0; qb < NQ; ++qb) o[qb][db] = __builtin_amdgcn_mfma_f32_16x16x32_bf16(vf, pb[qb][s2], o[qb][db], 0, 0, 0); \
                } \
        } } while (0)
    if (STG == 1) {
        AT_LOAD(0, t_lo);
        for (int t = t_lo; t < t_hi; ++t) {
            __syncthreads();
            AT_STORE(0);
            __syncthreads();
            if (t + 1 < t_hi) AT_LOAD(0, t + 1);
            AT_COMPUTE(t, 0);
        }
    } else {
        for (int tb = t_lo; tb < t_hi; tb += STG) {
#pragma unroll
            for (int j = 0; j < STG; ++j) if (tb + j < t_hi) AT_LOAD(j, tb + j);
            __syncthreads();
#pragma unroll
            for (int j = 0; j < STG; ++j) if (tb + j < t_hi) AT_STORE(j);
            __syncthreads();
#pragma unroll
            for (int j = 0; j < STG; ++j) if (tb + j < t_hi) AT_COMPUTE(tb + j, j * TILE_B);
        }
    }
#undef AT_LOAD
#undef AT_STORE
#undef AT_COMPUTE
#pragma unroll
    for (int qb = 0; qb < NQ; ++qb) {
        float l = lrun[qb]; l += __shfl_xor(l, 16); l += __shfl_xor(l, 32);
        if (MODE == 1) l += __builtin_amdgcn_exp2f(sink2 - mrun[qb]);
        const float inv = 1.0f / l;
        bf16_t* orow = Op + (size_t)(qw + 16 * qb + ql) * ldo + 4 * kq;
#pragma unroll
        for (int db = 0; db < NDB; ++db) { u32x2 w; w.x = cvt_pk_bf16(o[qb][db][0] * inv, o[qb][db][1] * inv); w.y = cvt_pk_bf16(o[qb][db][2] * inv, o[qb][db][3] * inv); *(u32x2*)(orow + 16 * db) = w; }
    }
}

namespace fox {
using bf16=__hip_bfloat16;
using s16x4=__attribute__((ext_vector_type(4)))short;
using f32x16=__attribute__((ext_vector_type(16)))float;
constexpr int NHEAD=8,SEQ=8192,D=64,DM=PROJ_LD;
constexpr int NW=8,QBLK=32,QB=QBLK*NW,KVBLK=64,NQB=SEQ/QB;
__device__ __forceinline__ int crow(int r,int hi){return (r&3)+8*(r>>2)+4*hi;}
#define SBAR() __builtin_amdgcn_sched_barrier(0)
__device__ __forceinline__ void cmask(f32x16&p0,f32x16&p1,int jb,int qrel,int hi){
  const float NEG=-INFINITY; int kb=64*jb+4*hi;
  #pragma unroll
  for(int r=0;r<16;++r){int kv=kb+(r&3)+8*(r>>2); if(kv>qrel)p0[r]=NEG; if(kv+32>qrel)p1[r]=NEG;}
}

constexpr int NSLOT=3, SLOTB=9216, XOFF=8192;
constexpr int LDS_K=0, LDS_V=NSLOT*SLOTB, LDS_WS=2*NSLOT*SLOTB, LDS_OST=LDS_WS+NW*64*4, LDS_BYTES=LDS_OST+NW*4096;
constexpr float C2=0.125f*1.4426950408889634f;
__device__ __forceinline__ void glds16(const void*gsrc,unsigned lds_dst){unsigned keep;
  asm volatile("s_mov_b32 %0, m0\n\ts_mov_b32 m0, %2\n\ts_nop 0\n\tglobal_load_lds_dwordx4 %1, off\n\ts_mov_b32 m0, %0":"=&s"(keep):"v"(gsrc),"s"(lds_dst):"memory");}
__device__ __forceinline__ float max3f(float a,float b,float c){float r;asm("v_max3_f32 %0, %1, %2, %3":"=v"(r):"v"(a),"v"(b),"v"(c));return r;}
__device__ __forceinline__ float max2f(float a,float b){float r;asm("v_max_f32_e32 %0, %1, %2":"=v"(r):"v"(a),"v"(b));return r;}
__device__ __forceinline__ float fadd_s(float a,float b){float r;asm("v_add_f32_e32 %0, %1, %2":"=v"(r):"v"(a),"v"(b));return r;}
__device__ __forceinline__ float fsub_s(float a,float b){float r;asm("v_sub_f32_e32 %0, %1, %2":"=v"(r):"v"(a),"v"(b));return r;}
typedef float f32x2_t __attribute__((ext_vector_type(2))); typedef __bf16 bf16x2_t __attribute__((ext_vector_type(2)));
__device__ __forceinline__ unsigned cvtpk_s(float lo,float hi){f32x2_t v={lo,hi};bf16x2_t b=__builtin_convertvector(v,bf16x2_t);return __builtin_bit_cast(unsigned,b);}
#define WAIT_BAR(N) asm volatile("s_waitcnt vmcnt(" #N ") lgkmcnt(0)\n\ts_barrier":::"memory")
#define WAIT_BARK2() do{ if(wid==0){WAIT_BAR(3);} else {WAIT_BAR(2);} }while(0)

__device__ __forceinline__ void qkt(f32x16&p0,f32x16&p1,const char*Kslot,const bf16x8*qr,const bf16x8&qxa,const bf16x8&qxb,int r32,int hi,int lane){
  const f32x16 z16=f32x16{};
  const char*kb=Kslot+hi*1024+r32*16;
  #pragma unroll
  for(int d0=0;d0<4;++d0){
    const bf16x8 b0=*reinterpret_cast<const bf16x8*>(kb+d0*2048);
    const bf16x8 b1=*reinterpret_cast<const bf16x8*>(kb+d0*2048+512);
    if(d0==0){p0=__builtin_amdgcn_mfma_f32_32x32x16_bf16(b0,qr[0],z16,0,0,0);p1=__builtin_amdgcn_mfma_f32_32x32x16_bf16(b1,qr[0],z16,0,0,0);}
    else{p0=__builtin_amdgcn_mfma_f32_32x32x16_bf16(b0,qr[d0],p0,0,0,0);p1=__builtin_amdgcn_mfma_f32_32x32x16_bf16(b1,qr[d0],p1,0,0,0);}}
  const bf16x8 kx=*reinterpret_cast<const bf16x8*>(Kslot+XOFF+lane*16);
  p0=__builtin_amdgcn_mfma_f32_32x32x16_bf16(kx,qxa,p0,0,0,0);p1=__builtin_amdgcn_mfma_f32_32x32x16_bf16(kx,qxb,p1,0,0,0);
}
typedef __attribute__((address_space(3))) const char* lds_cptr;
typedef short v4i16_t __attribute__((ext_vector_type(4)));
__device__ __forceinline__ void kload8(bf16x8*kf,lds_cptr kp){
  kf[0]=*(const __attribute__((address_space(3))) bf16x8*)(kp);      kf[1]=*(const __attribute__((address_space(3))) bf16x8*)(kp+512);
  kf[2]=*(const __attribute__((address_space(3))) bf16x8*)(kp+2048); kf[3]=*(const __attribute__((address_space(3))) bf16x8*)(kp+2560);
  kf[4]=*(const __attribute__((address_space(3))) bf16x8*)(kp+4096); kf[5]=*(const __attribute__((address_space(3))) bf16x8*)(kp+4608);
  kf[6]=*(const __attribute__((address_space(3))) bf16x8*)(kp+6144); kf[7]=*(const __attribute__((address_space(3))) bf16x8*)(kp+6656);
}
__device__ __forceinline__ void kload2(bf16x8*kf,lds_cptr kp,int j){ kf[2*j]=*(const __attribute__((address_space(3))) bf16x8*)(kp+j*2048); kf[2*j+1]=*(const __attribute__((address_space(3))) bf16x8*)(kp+j*2048+512); }
__device__ __forceinline__ s16x4 vtr(lds_cptr p){ return __builtin_bit_cast(s16x4,__builtin_amdgcn_ds_read_tr16_b64_v4i16((__attribute__((address_space(3))) v4i16_t*)p)); }
__device__ __forceinline__ float rowmax(const f32x16&p0,const f32x16&p1){
  float a=max3f(p0[0],p0[1],p1[0]),b=max3f(p0[2],p0[3],p1[1]);a=max3f(a,p1[2],p1[3]);
  #pragma unroll
  for(int r=4;r<16;r+=4){a=max3f(a,p0[r],p0[r+1]);b=max3f(b,p0[r+2],p0[r+3]);a=max3f(a,p1[r],p1[r+1]);b=max3f(b,p1[r+2],p1[r+3]);}
  const float m=max2f(a,b);
  auto rr=__builtin_amdgcn_permlane32_swap(__float_as_uint(m),__float_as_uint(m),false,false);
  return max2f(__uint_as_float(rr[0]),__uint_as_float(rr[1]));
}
__device__ __forceinline__ void pv(f32x16*o,int vb,bf16x8 pa0,bf16x8 pa1,bf16x8 pa2,bf16x8 pa3){
  #pragma unroll
  for(int d0=0;d0<2;++d0){s16x4 lo[4],hi[4];
    #pragma unroll
    for(int ks=0;ks<4;++ks){
      asm volatile("ds_read_b64_tr_b16 %0,%1 offset:%c2":"=&v"(lo[ks]):"v"(vb),"i"(d0*4096+ks*1024):"memory");
      asm volatile("ds_read_b64_tr_b16 %0,%1 offset:%c2":"=&v"(hi[ks]):"v"(vb),"i"(d0*4096+ks*1024+512):"memory");}
    asm volatile("s_waitcnt lgkmcnt(0)":::"memory");SBAR();
    #define PK(k) (bf16x8){lo[k][0],lo[k][1],lo[k][2],lo[k][3],hi[k][0],hi[k][1],hi[k][2],hi[k][3]}
    o[d0]=__builtin_amdgcn_mfma_f32_32x32x16_bf16(pa0,PK(0),o[d0],0,0,0);
    o[d0]=__builtin_amdgcn_mfma_f32_32x32x16_bf16(pa1,PK(1),o[d0],0,0,0);
    o[d0]=__builtin_amdgcn_mfma_f32_32x32x16_bf16(pa2,PK(2),o[d0],0,0,0);
    o[d0]=__builtin_amdgcn_mfma_f32_32x32x16_bf16(pa3,PK(3),o[d0],0,0,0);
    #undef PK
  }
}

#ifndef ATTN_STORE16
#define ATTN_STORE16(p,v) (*(u32x4*)(p)=(v))
#endif
template<int THRL> __device__ __forceinline__ void attn_unit(int b,int h,int qb,const bf16*Q,const bf16*__restrict__ K,const bf16*__restrict__ V,const bf16*__restrict__ KX,bf16*O,char*shm,int t0){
  int tid_=threadIdx.x; asm volatile("":"+v"(tid_)); const int tid=tid_,lane=tid&63,r32=lane&31,hi=lane>>5; const int wid=__builtin_amdgcn_readfirstlane(tid>>6);
  const long rowbase=(long)b*SEQ; const int q0=qb*QB;
  const bf16*Qw=Q+(rowbase+q0+wid*QBLK)*DM+h*D;
  const bf16*Kh=K+(rowbase+(long)t0*KVBLK)*DM+h*D,*Vh=V+(rowbase+(long)t0*KVBLK)*DM+h*D;
  const unsigned lds0=(unsigned)(uintptr_t)shm;
  float*wsf=(float*)(shm+LDS_WS)+wid*64;
  const bf16*ksrc=Kh+(long)lane*DM+wid*8;
  const bf16*vsrc=Vh+(long)(16*(wid&3)+(lane>>2))*DM+(wid>>2)*32+(lane&3)*8;
  const bf16*xsrc=KX+((long)t0*KVBLK+lane)*8;
  const unsigned kdst=lds0+LDS_K+wid*1024, vdst=lds0+LDS_V+wid*1024;
  #define DMA_K(t,slot) do{ glds16(ksrc+(long)(t)*KVBLK*DM,(unsigned)__builtin_amdgcn_readfirstlane(kdst+(slot))); if(wid==0) glds16(xsrc+(long)(t)*KVBLK*8,(unsigned)__builtin_amdgcn_readfirstlane(lds0+LDS_K+XOFF+(slot))); }while(0)
  #define DMA_V(t,slot) glds16(vsrc+(long)(t)*KVBLK*DM,(unsigned)__builtin_amdgcn_readfirstlane(vdst+(slot)))
  const int vb0=(int)(lds0+LDS_V)+((lane>>4)&1)*32+(lane&3)*8+(4*hi+((lane&15)>>2))*64;
  const char*Kbase=shm+LDS_K; bf16x8 kf[8];
  const lds_cptr shm3=(lds_cptr)shm; const lds_cptr xp0=shm3+LDS_K+XOFF+lane*16; const lds_cptr kp0=shm3+LDS_K+hi*1024+r32*16; const lds_cptr vp0=shm3+LDS_V+((lane>>4)&1)*32+(lane&3)*8+(4*hi+((lane&15)>>2))*64;
  const int NT=(q0+QB)/KVBLK-t0;
  DMA_K(0,0);DMA_V(0,0);DMA_K(1,SLOTB);
  bf16x8 qr[4];
  #pragma unroll
  for(int d0=0;d0<4;++d0)qr[d0]=*reinterpret_cast<const bf16x8*>(&Qw[(long)r32*DM+d0*16+hi*8]);
  float mhat=0.f,l_reg=0.f;f32x16 o[2];o[0]=f32x16{};o[1]=f32x16{};bf16x8 qxa,qxb,kxf; const f32x16 z16=f32x16{};
  #define SETQX(mh) do{ const float v_=-(mh); const unsigned a_=cvtpk_s(v_,0.f)&0xffffu; const float r1_=v_-__uint_as_float(a_<<16); const unsigned b_=cvtpk_s(r1_,0.f)&0xffffu; const float r2_=r1_-__uint_as_float(b_<<16); const unsigned c_=cvtpk_s(r2_,0.f)&0xffffu; \
    const u32x4 w_={0x3f803f80u,0x3f80u|(a_<<16),b_|(c_<<16),0u}; const u32x4 z_={0u,0u,0u,0u}; qxa=__builtin_bit_cast(bf16x8,hi?z_:w_); qxb=__builtin_bit_cast(bf16x8,hi?w_:z_); asm volatile("":"+v"(qxa),"+v"(qxb)); }while(0)
  SETQX(0.f);
  const int qrel=wid*QBLK+r32;
  #define CMASK(P0,P1,t) do{int jb_=(t)-(NT-4); if(jb_>=0)cmask(P0,P1,jb_,qrel,hi);}while(0)
  bool resc=false;
  #define START(P0,P1) do{ const float rm=rowmax(P0,P1); resc=false; \
    { const float dl=rm; mhat=fadd_s(mhat,dl); \
      _Pragma("unroll") for(int r=0;r<16;++r){P0[r]=fsub_s(P0[r],dl);P1[r]=fsub_s(P1[r],dl);} \
      SETQX(mhat); } \
    _Pragma("unroll") for(int r=0;r<16;++r)P0[r]=__builtin_amdgcn_exp2f(P0[r]); }while(0)
  #define RESC() do{ if(resc){ asm volatile("s_waitcnt lgkmcnt(0)":::"memory"); \
      _Pragma("unroll") for(int d_=0;d_<2;++d_) _Pragma("unroll") for(int r=0;r<16;++r)o[d_][r]*=wsf[crow(r,hi)]; } }while(0)
  f32x16 pA0,pA1,pB0,pB1;
  int sl_prev=0,sl_cur=0,sl_next=SLOTB;
  #define ROT() do{sl_prev=sl_cur;sl_cur=sl_next;sl_next=(sl_next==(NSLOT-1)*SLOTB)?0:sl_next+SLOTB;}while(0)
  DMA_K(2,2*SLOTB);
  WAIT_BAR(3);
  qkt(pA0,pA1,Kbase,qr,qxa,qxb,r32,hi,lane);asm volatile("s_nop 15\n\ts_nop 7":"+v"(pA0),"+v"(pA1));CMASK(pA0,pA1,0);
  START(pA0,pA1);
  _Pragma("unroll") for(int r=0;r<16;++r)pA1[r]=__builtin_amdgcn_exp2f(pA1[r]);
  WAIT_BAR(0);
  DMA_K(3,0);DMA_V(1,SLOTB);
  ROT();
  kload8(kf,kp0+sl_cur); kxf=*(const __attribute__((address_space(3))) bf16x8*)(xp0+sl_cur);
  WAIT_BARK2();
  s16x4 vlo[8],vhi[8]; u32x4 pw0,pw1,pw2,pw3;
  #define PKW(P,B) cvtpk_s(P[B],P[B+1])
  #define PAF(k) __builtin_bit_cast(bf16x8,pw##k)
  #define VFR(i) (bf16x8){vlo[i][0],vlo[i][1],vlo[i][2],vlo[i][3],vhi[i][0],vhi[i][1],vhi[i][2],vhi[i][3]}
  #define PIN(x) asm volatile("":"+v"(x))
  #define MX3(a,b,c) __builtin_fmaxf(__builtin_fmaxf((a),(b)),(c))
  #define GAPA(MF,A0,A1,A2,A3,W0,W1,PW) do{ MF; sacc+=A0; sacc+=A1; sacc+=A2; sacc+=A3; PIN(sacc); W0; W1; PIN(PW); SBAR(); }while(0)
  #define EX(v) __builtin_amdgcn_exp2f(v)
  #define GAPB(MF,X,B) do{ MF; X[B]=EX(X[B]); X[B+1]=EX(X[B+1]); X[B+2]=EX(X[B+2]); X[B+3]=EX(X[B+3]); PIN(X); SBAR(); }while(0)
  #define VRD(i) do{ vlo[i]=vtr(vp_+(((i)>>2)*4096+((i)&3)*1024)); vhi[i]=vtr(vp_+(((i)>>2)*4096+((i)&3)*1024+512)); }while(0)
  #define KRD(G,j) do{ if(G){ kload2(kf,kp0+sl_next,j); if((j)==3) kxf=*(const __attribute__((address_space(3))) bf16x8*)(xp0+sl_next); SBAR(); } }while(0)
  #define STEP(C0,C1,P0,P1,t,GK,GV,GL) do{ SBAR(); \
    const lds_cptr vp_=vp0+sl_prev; \
    VRD(0); SBAR(); float sacc=(P0[0]+P0[1]); \
    GAPA(C0=__builtin_amdgcn_mfma_f32_32x32x16_bf16(kf[0],qr[0],z16,0,0,0), P0[2],P0[3],P0[4],P0[5],     pw0[0]=PKW(P0,0), pw0[1]=PKW(P0,2), pw0); \
    VRD(4); SBAR(); GAPA(C1=__builtin_amdgcn_mfma_f32_32x32x16_bf16(kf[1],qr[0],z16,0,0,0), P0[6],P0[7],P0[8],P0[9],     pw0[2]=PKW(P0,4), pw0[3]=PKW(P0,6), pw0); \
    VRD(1); SBAR(); GAPA(C0=__builtin_amdgcn_mfma_f32_32x32x16_bf16(kf[2],qr[1],C0,0,0,0),   P0[10],P0[11],P0[12],P0[13], pw1[0]=PKW(P0,8), pw1[1]=PKW(P0,10), pw1); \
    VRD(5); SBAR(); GAPA(C1=__builtin_amdgcn_mfma_f32_32x32x16_bf16(kf[3],qr[1],C1,0,0,0),   P0[14],P0[15],P1[0],P1[1],   pw1[2]=PKW(P0,12),pw1[3]=PKW(P0,14), pw1); \
    VRD(2); SBAR(); GAPA(C0=__builtin_amdgcn_mfma_f32_32x32x16_bf16(kf[4],qr[2],C0,0,0,0),   P1[2],P1[3],P1[4],P1[5],     pw2[0]=PKW(P1,0), pw2[1]=PKW(P1,2), pw2); \
    VRD(6); SBAR(); GAPA(C1=__builtin_amdgcn_mfma_f32_32x32x16_bf16(kf[5],qr[2],C1,0,0,0),   P1[6],P1[7],P1[8],P1[9],     pw2[2]=PKW(P1,4), pw2[3]=PKW(P1,6), pw2); \
    VRD(3); SBAR(); GAPA(C0=__builtin_amdgcn_mfma_f32_32x32x16_bf16(kf[6],qr[3],C0,0,0,0),   P1[10],P1[11],P1[12],P1[13], pw3[0]=PKW(P1,8), pw3[1]=PKW(P1,10), pw3); \
    VRD(7); SBAR(); GAPA(C1=__builtin_amdgcn_mfma_f32_32x32x16_bf16(kf[7],qr[3],C1,0,0,0),   P1[14],P1[15],0.f,0.f,       pw3[2]=PKW(P1,12),pw3[3]=PKW(P1,14), pw3); \
    C0=__builtin_amdgcn_mfma_f32_32x32x16_bf16(kxf,qxa,C0,0,0,0); C1=__builtin_amdgcn_mfma_f32_32x32x16_bf16(kxf,qxb,C1,0,0,0); SBAR(); \
    l_reg+=sacc; \
    if(GK){DMA_K((t)+3,sl_cur);} if(GV){DMA_V((t)+1,sl_next);} \
    CMASK(C0,C1,t); \
    { float a=MX3(C0[0],C0[1],C1[0]),b=MX3(C0[2],C0[3],C1[1]); a=MX3(a,C1[2],C1[3]); \
      _Pragma("unroll") for(int r=4;r<16;r+=4){a=MX3(a,C0[r],C0[r+1]);b=MX3(b,C0[r+2],C0[r+3]);a=MX3(a,C1[r],C1[r+1]);b=MX3(b,C1[r+2],C1[r+3]);} \
      float rm=__builtin_fmaxf(a,b); { auto rr=__builtin_amdgcn_permlane32_swap(__float_as_uint(rm),__float_as_uint(rm),false,false); rm=__builtin_fmaxf(__uint_as_float(rr[0]),__uint_as_float(rr[1])); } \
      resc=false; \
      if(__builtin_expect(__any(rm>(float)THRL),0)){ const float dl=__builtin_fmaxf(rm,0.f); mhat+=dl; \
        _Pragma("unroll") for(int r=0;r<16;++r){C0[r]-=dl;C1[r]-=dl;} \
        SETQX(mhat); \
        const float f=__builtin_amdgcn_exp2f(-dl); l_reg*=f; if(hi==0)wsf[r32]=f; resc=true; } } \
    SBAR(); \
    GAPB(o[0]=__builtin_amdgcn_mfma_f32_32x32x16_bf16(PAF(0),VFR(0),o[0],0,0,0), C0,0); \
    GAPB(o[1]=__builtin_amdgcn_mfma_f32_32x32x16_bf16(PAF(0),VFR(4),o[1],0,0,0), C0,4); \
    KRD(GL,0); GAPB(o[0]=__builtin_amdgcn_mfma_f32_32x32x16_bf16(PAF(1),VFR(1),o[0],0,0,0), C0,8); \
    KRD(GL,1); GAPB(o[1]=__builtin_amdgcn_mfma_f32_32x32x16_bf16(PAF(1),VFR(5),o[1],0,0,0), C0,12); \
    KRD(GL,2); GAPB(o[0]=__builtin_amdgcn_mfma_f32_32x32x16_bf16(PAF(2),VFR(2),o[0],0,0,0), C1,0); \
    KRD(GL,3); GAPB(o[1]=__builtin_amdgcn_mfma_f32_32x32x16_bf16(PAF(2),VFR(6),o[1],0,0,0), C1,4); \
    GAPB(o[0]=__builtin_amdgcn_mfma_f32_32x32x16_bf16(PAF(3),VFR(3),o[0],0,0,0), C1,8); \
    GAPB(o[1]=__builtin_amdgcn_mfma_f32_32x32x16_bf16(PAF(3),VFR(7),o[1],0,0,0), C1,12); \
    }while(0)
  int t=1;
  #undef CMASK
  #define CMASK(P0,P1,t) do{}while(0)
  for(;t+5<NT;t+=2){
    STEP(pB0,pB1,pA0,pA1,t,true,true,true);     WAIT_BARK2(); RESC(); ROT();
    STEP(pA0,pA1,pB0,pB1,t+1,true,true,true);   WAIT_BARK2(); RESC(); ROT();
  }
  #undef CMASK
  #define CMASK(P0,P1,t) do{int jb_=(t)-(NT-4); if(jb_>=0)cmask(P0,P1,jb_,qrel,hi);}while(0)
  #define ENDW(tt) do{ if((tt)+3<NT){WAIT_BARK2();} else if((tt)+2<NT){WAIT_BAR(1);} else {WAIT_BAR(0);} }while(0)
  for(;t+1<NT;t+=2){
    STEP(pB0,pB1,pA0,pA1,t,(t+3<NT),(t+1<NT),(t+1<NT));       ENDW(t);   RESC(); ROT();
    STEP(pA0,pA1,pB0,pB1,t+1,(t+4<NT),(t+2<NT),(t+2<NT));     ENDW(t+1); RESC(); ROT();
  }
  STEP(pB0,pB1,pA0,pA1,NT-1,false,false,false); RESC();
  { float sacc=pB0[0]+pB0[1]; _Pragma("unroll") for(int r=2;r<16;++r)sacc+=pB0[r]; _Pragma("unroll") for(int r=0;r<16;++r)sacc+=pB1[r]; l_reg+=sacc;
    pw0=(u32x4){PKW(pB0,0),PKW(pB0,2),PKW(pB0,4),PKW(pB0,6)};pw1=(u32x4){PKW(pB0,8),PKW(pB0,10),PKW(pB0,12),PKW(pB0,14)};pw2=(u32x4){PKW(pB1,0),PKW(pB1,2),PKW(pB1,4),PKW(pB1,6)};pw3=(u32x4){PKW(pB1,8),PKW(pB1,10),PKW(pB1,12),PKW(pB1,14)};
    SBAR(); pv(o,vb0+sl_cur,PAF(0),PAF(1),PAF(2),PAF(3)); }
  #undef PKW
  #undef PAF
  #undef VFR
  #undef PIN
  #undef MX3
  #undef GAPA
  #undef GAPB
  #undef EX
  #undef VRD
  #undef KRD
  #undef STEP
  #undef ENDW
  {auto rr=__builtin_amdgcn_permlane32_swap(__float_as_uint(l_reg),__float_as_uint(l_reg),false,false);l_reg=__uint_as_float(rr[0])+__uint_as_float(rr[1]);}
  if(hi==0)wsf[32+r32]=l_reg;asm volatile("s_waitcnt lgkmcnt(0)":::"memory");
  float rli[16];
  #pragma unroll
  for(int r=0;r<16;++r)rli[r]=__builtin_amdgcn_rcpf(wsf[32+crow(r,hi)]);
  bf16*Ow=O+(rowbase+q0+wid*QBLK)*DM+h*D;
  { bf16*stg=(bf16*)(shm+LDS_OST)+wid*2048;
    #pragma unroll
    for(int r=0;r<16;++r){const int orow=crow(r,hi);
      #pragma unroll
      for(int d0=0;d0<2;++d0)stg[orow*64+d0*32+r32]=__float2bfloat16(o[d0][r]*rli[r]);}
    asm volatile("s_waitcnt lgkmcnt(0)":::"memory");
    #pragma unroll
    for(int i=0;i<4;++i){const int row=i*8+(lane>>3),ch=lane&7; const u32x4 v=*(const u32x4*)(stg+row*64+ch*8); ATTN_STORE16(Ow+(long)row*DM+ch*8,v);} }
  asm volatile("s_waitcnt lgkmcnt(0)\n\ts_barrier":::"memory");
  #undef DMA_K
  #undef DMA_V
  #undef CMASK
  #undef START
  #undef RESC
  #undef ROT
  #undef SETQX
}
constexpr int ATTN_LDS_BYTES=LDS_BYTES;
#undef SBAR
#undef WAIT_BAR
#undef WAIT_BARK2
}

__device__ __forceinline__ float wave_sum(float v) {
#pragma unroll
    for (int o = 1; o < 64; o <<= 1) v += __shfl_xor(v, o);
    return v;
}
__device__ __forceinline__ void tr_item(const float* W, int ldw, int src_col0, int nvalid, const float* g, bf16_t* WT, int ldt, int dst_row0, int dst_col0, int k0, LAS float* scr, int lane) {
    const int ks = lane >> 4, n4 = (lane & 15) * 4;
    f32x4 v[16];
#pragma unroll
    for (int i = 0; i < 16; ++i) v[i] = (n4 < nvalid) ? *(const f32x4*)(W + (size_t)(k0 + 4 * i + ks) * ldw + src_col0 + n4) : (f32x4){0.f, 0.f, 0.f, 0.f};
#pragma unroll
    for (int i = 0; i < 16; ++i) { const int kk = 4 * i + ks; const float gg = g ? g[k0 + kk] : 1.0f;
        scr[kk * 65 + n4] = v[i][0] * gg; scr[kk * 65 + n4 + 1] = v[i][1] * gg; scr[kk * 65 + n4 + 2] = v[i][2] * gg; scr[kk * 65 + n4 + 3] = v[i][3] * gg; }
    asm volatile("s_waitcnt lgkmcnt(0)" ::: "memory");
    const int c = lane & 7;
#pragma unroll
    for (int j = 0; j < 8; ++j) { const int n = (lane >> 3) + 8 * j; const LAS float* s = scr + (8 * c) * 65 + n;
        u32x4 o; o.x = cvt_pk_bf16(s[0 * 65], s[1 * 65]); o.y = cvt_pk_bf16(s[2 * 65], s[3 * 65]); o.z = cvt_pk_bf16(s[4 * 65], s[5 * 65]); o.w = cvt_pk_bf16(s[6 * 65], s[7 * 65]);
        *(u32x4*)(WT + (size_t)(dst_row0 + n) * ldt + dst_col0 + k0 + 8 * c) = o; }
    asm volatile("s_waitcnt lgkmcnt(0)" ::: "memory");
}
__device__ __forceinline__ void tr_job(const float* W, int ldw, int K, int src_col0, int nrows, int nvalid_total, const float* g, bf16_t* WT, int ldt, int dst_row0, int dst_col0, LAS float* scr, int lane, int gw, int NGW) {
    const int nblk = nrows / 64, nit = (K / 64) * nblk;
    for (int it = gw; it < nit; it += NGW) { const int kb = it / nblk, nb = it % nblk; int nv = nvalid_total - 64 * nb; nv = nv > 64 ? 64 : nv;
        tr_item(W, ldw, src_col0 + 64 * nb, nv, g, WT, ldt, dst_row0 + 64 * nb, dst_col0, 64 * kb, scr, lane); }
}
template <int NR> __device__ __forceinline__ void rows_to_bf16(const float* x, bf16_t* o, float* p, int m0, int rs, int lane) {
    f32x4 v[NR][4];
#pragma unroll
    for (int r = 0; r < NR; ++r) { const f32x4* xr = (const f32x4*)(x + (size_t)(m0 + r * rs) * DM) + lane;
#pragma unroll
        for (int j = 0; j < 4; ++j) v[r][j] = xr[64 * j]; }
#pragma unroll
    for (int r = 0; r < NR; ++r) {
        float s = 0.f;
#pragma unroll
        for (int j = 0; j < 4; ++j) s += (v[r][j][0] * v[r][j][0] + v[r][j][1] * v[r][j][1]) + (v[r][j][2] * v[r][j][2] + v[r][j][3] * v[r][j][3]);
        s = wave_sum(s);
        u32x2* o8 = (u32x2*)(o + (size_t)(m0 + r * rs) * DM) + lane;
#pragma unroll
        for (int j = 0; j < 4; ++j) { u32x2 w; w.x = cvt_pk_bf16(v[r][j][0], v[r][j][1]); w.y = cvt_pk_bf16(v[r][j][2], v[r][j][3]); o8[64 * j] = w; }
        if (lane < 16) p[(size_t)(m0 + r * rs) * 16 + lane] = (lane == 0) ? s : 0.f;
    }
}


#define RLX_AGENT __ATOMIC_RELAXED, __HIP_MEMORY_SCOPE_AGENT
#define XB_TMO      128
#define XB_XCNT(j)  (256  + 64 * (j))
#define XB_XSUB(j)  (1280 + 64 * (j))
#define XB_XGEN(j)  (2304 + 64 * (j))
#define XB_TOP      3328
#define XB_TOPGEN   3392
#define XCD_BAR_WORDS 3456
#define XB_SPIN_CAP (1u << 18)

__device__ __forceinline__ unsigned xb_ld(unsigned* p)              { return __hip_atomic_load(p, __ATOMIC_RELAXED, __HIP_MEMORY_SCOPE_AGENT); }
__device__ __forceinline__ unsigned xb_add(unsigned* p, unsigned v) { return __hip_atomic_fetch_add(p, v, __ATOMIC_RELAXED, __HIP_MEMORY_SCOPE_AGENT); }
__device__ __forceinline__ unsigned xb_xcc_id() { return (unsigned)__builtin_amdgcn_s_getreg((3 << 11) | 20) & 0xFu; }
#define XB_SPIN(cond, bar) do { unsigned _sp = 0; while (cond) { __builtin_amdgcn_s_sleep(1); \
    if ((++_sp & 255u) == 0u) { if (xb_ld(&(bar)[XB_TMO])) break; if (_sp > XB_SPIN_CAP) { atomicAdd(&(bar)[XB_TMO], 1u); break; } } } } while (0)

struct XcdBarrier {
    unsigned* bar; unsigned x;
    volatile LAS unsigned* st;
};

__device__ __forceinline__ XcdBarrier xcd_barrier_post(unsigned* bar, volatile LAS unsigned* st) {
    XcdBarrier b; b.bar = bar; b.x = xb_xcc_id(); b.st = st;
    if (threadIdx.x == 0) (void)xb_add(&bar[XB_XCNT(b.x)], 1u);
    return b;
}
__device__ __forceinline__ void xcd_barrier_complete(unsigned* bar, unsigned x, unsigned& nloc, unsigned& nx) {
    const unsigned G = gridDim.x * gridDim.y * gridDim.z;
    unsigned sum, cnt, mine, sp = 0u;
    for (;;) {
        sum = 0u; cnt = 0u; mine = 0u;
#pragma unroll
        for (unsigned j = 0; j < 16; ++j) { const unsigned c = xb_ld(&bar[XB_XCNT(j)]); sum += c; cnt += (c > 0u) ? 1u : 0u; mine = (j == x) ? c : mine; }
        if (sum == G) break;
        __builtin_amdgcn_s_sleep(1);
        if ((++sp & 255u) == 0u) { if (xb_ld(&bar[XB_TMO])) break; if (sp > XB_SPIN_CAP) { atomicAdd(&bar[XB_TMO], 1u); break; } }
    }
    nloc = mine > 0u ? mine : 1u; nx = cnt > 0u ? cnt : 1u;
}

__device__ __forceinline__ void xcd_barrier(const XcdBarrier& b) {
    asm volatile("s_waitcnt vmcnt(0)" ::: "memory");
    __syncthreads();
    if (threadIdx.x == 0) {
        unsigned* bar = b.bar;
        __builtin_amdgcn_s_waitcnt(0);
        unsigned nloc = b.st[0], nx = b.st[1];
        if (nloc == 0u) { xcd_barrier_complete(bar, b.x, nloc, nx); b.st[0] = nloc; b.st[1] = nx; }
        const unsigned old = xb_add(&bar[XB_XSUB(b.x)], 1u);
        const unsigned gen = old / nloc;
        if (old + 1u == (gen + 1u) * nloc) {
            __builtin_amdgcn_fence(__ATOMIC_RELEASE, "agent");
            asm volatile("s_waitcnt vmcnt(0)" ::: "memory");
            const unsigned og = xb_add(&bar[XB_TOP], 1u);
            const unsigned tg = og / nx;
            if (og + 1u == (tg + 1u) * nx) xb_add(&bar[XB_TOPGEN], 1u);
            else XB_SPIN(xb_ld(&bar[XB_TOPGEN]) == tg, bar);
            __builtin_amdgcn_fence(__ATOMIC_ACQUIRE, "agent");
            xb_add(&bar[XB_XGEN(b.x)], 1u);
            asm volatile("s_waitcnt vmcnt(0)" ::: "memory");
        } else {
            XB_SPIN(xb_ld(&bar[XB_XGEN(b.x)]) == gen, bar);
            __builtin_amdgcn_fence(__ATOMIC_ACQUIRE, "agent");
            asm volatile("s_waitcnt vmcnt(0)" ::: "memory");
        }
    }
    __syncthreads();
}

struct Args { const float* in[20]; float* out; unsigned char* ws; int ph_lo, ph_hi, nch, pad; };

__global__ void __launch_bounds__(512, 2) mk_fwd(Args args) {
    extern __shared__ __attribute__((aligned(16))) unsigned char lds_raw[];
    LAS unsigned char* lds = (LAS unsigned char*)lds_raw;
    cg::grid_group grid = cg::this_grid();
    const int tid = threadIdx.x, lane = tid & 63, wave = __builtin_amdgcn_readfirstlane(tid >> 6);
    const int G = gridDim.x, bx = blockIdx.x;
    const int vcu = (G % 8 == 0) ? (bx % 8) * (G / 8) + bx / 8 : bx;
    const int gw = vcu * 8 + wave, NGW = G * 8;
    unsigned char* ws = args.ws;
    const float* x_in = args.in[0]; const float* mem_in = args.in[1];
    float* X = args.out;
    float* part = (float*)(ws + WS_PART); float* partM = (float*)(ws + WS_PARTM); float* logf = (float*)(ws + WS_LOGF);
    unsigned char* dsc = (unsigned char*)args.out;
    bf16_t* memb = (bf16_t*)(dsc + DO_MEMB); bf16_t* KVm = (bf16_t*)(dsc + DO_KVM); bf16_t* WKVT = (bf16_t*)(dsc + DO_WKVT);
    bf16_t* Xb = (bf16_t*)(ws + WS_XB); bf16_t* BIG = (bf16_t*)(ws + WS_BIG);
    const int NCH = args.nch, TC = TOK / NCH, BPC = NB / NCH;
    const int lo = args.ph_lo, hi = args.ph_hi; int ph = 0;
#define PH_ON (ph >= lo && ph < hi)
#define MK_CAT2(a, b) a##b
#define MK_CAT(a, b) MK_CAT2(a, b)
#define PH_BAR() do { if (args.pad == 0x5eed) grid.sync(); else xcd_barrier(bar); } while (0)
    int dup_cnt = 0; (void)dup_cnt;
#define PH_END_PLAIN() do { if (ph >= lo && ph + 1 < hi) PH_BAR(); ++ph; } while (0)
#define PH_END_DUP() do { if (ph >= lo && ph + 1 < hi) PH_BAR(); if (dup_cnt < MK_DUPN) { ++dup_cnt; ph -= (MK_DUP_HI - MK_DUP_LO); goto MK_CAT(DUPL_, MK_DUP_LO); } ++ph; } while (0)
#define PH_BEGIN(ty) if ((ty) == MK_DUP_LO) dup_cnt = 0; MK_CAT(DUPL_, ty): if (PH_ON) {
#define PH_END(ty) MK_CAT(PH_END_, ty)()
#if MK_DUP_HI == 0
#define PH_END_0() PH_END_DUP()
#else
#define PH_END_0() PH_END_PLAIN()
#endif
#if MK_DUP_HI == 1
#define PH_END_1() PH_END_DUP()
#else
#define PH_END_1() PH_END_PLAIN()
#endif
#if MK_DUP_HI == 2
#define PH_END_2() PH_END_DUP()
#else
#define PH_END_2() PH_END_PLAIN()
#endif
#if MK_DUP_HI == 3
#define PH_END_3() PH_END_DUP()
#else
#define PH_END_3() PH_END_PLAIN()
#endif
#if MK_DUP_HI == 4
#define PH_END_4() PH_END_DUP()
#else
#define PH_END_4() PH_END_PLAIN()
#endif
#if MK_DUP_HI == 5
#define PH_END_5() PH_END_DUP()
#else
#define PH_END_5() PH_END_PLAIN()
#endif
#if MK_DUP_HI == 6
#define PH_END_6() PH_END_DUP()
#else
#define PH_END_6() PH_END_PLAIN()
#endif
#if MK_DUP_HI == 7
#define PH_END_7() PH_END_DUP()
#else
#define PH_END_7() PH_END_PLAIN()
#endif
#if MK_DUP_HI == 8
#define PH_END_8() PH_END_DUP()
#else
#define PH_END_8() PH_END_PLAIN()
#endif
#if MK_DUP_HI == 9
#define PH_END_9() PH_END_DUP()
#else
#define PH_END_9() PH_END_PLAIN()
#endif
#if MK_DUP_HI == 10
#define PH_END_10() PH_END_DUP()
#else
#define PH_END_10() PH_END_PLAIN()
#endif
#if MK_DUP_HI == 11
#define PH_END_11() PH_END_DUP()
#else
#define PH_END_11() PH_END_PLAIN()
#endif
#if MK_DUP_HI == 12
#define PH_END_12() PH_END_DUP()
#else
#define PH_END_12() PH_END_PLAIN()
#endif
    volatile LAS unsigned* MISC = (volatile LAS unsigned*)(lds + 146432);
    if (tid < 32) MISC[tid] = 0u;
    __syncthreads();
    XcdBarrier bar; bar.bar = (unsigned*)ws; bar.x = 0; bar.st = nullptr;
    if (hi - lo > 1) bar = xcd_barrier_post((unsigned*)ws, MISC + 8);

    PH_BEGIN(0)
        LAS float* scr = (LAS float*)(lds + wave * 16640);
        for (int l = 0; l < DEPTH; ++l) {
            unsigned char* wl = dsc + DO_W + (size_t)l * W_LAYER;
            bf16_t* W1T = (bf16_t*)(wl + WO_W1T);
            const float* w_in = args.in[3] + (size_t)l * DM * IN_COLS; const float* mixg = args.in[2] + l * DM;
            tr_job(w_in, IN_COLS, DM, 0, 3072, 3072, mixg, W1T, DM, 0, 0, scr, lane, gw, NGW);
            tr_job(w_in, IN_COLS, DM, 3080, 3840, 3840, mixg, W1T, DM, 3072, 0, scr, lane, gw, NGW);
            tr_job(w_in, IN_COLS, DM, 3072, 64, 8, mixg, W1T, DM, 6912, 0, scr, lane, gw, NGW);
            for (int i = gw * 64 + lane; i < 192 * DM / 8; i += NGW * 64) *(u32x4*)(W1T + (size_t)6976 * DM + (size_t)i * 8) = (u32x4){0u, 0u, 0u, 0u};
            for (int b = 0; b < 3; ++b) tr_job(args.in[7] + ((size_t)l * 3 + b) * 512 * DM, DM, 512, 0, DM, DM, nullptr, (bf16_t*)(wl + WO_WBT), 1536, 0, 512 * b, scr, lane, gw, NGW);
            tr_job(args.in[8] + (size_t)l * DM * DM, DM, DM, 0, DM, DM, nullptr, (bf16_t*)(wl + WO_WOT), DM, 0, 0, scr, lane, gw, NGW);
            {
                const float* wq = args.in[12] + (size_t)l * DM * DM; const float* gq = args.in[10] + l * DM; bf16_t* WQ2 = (bf16_t*)(wl + WO_WXQT);
                for (int i = gw * 64 + lane; i < DM * DM / 8; i += NGW * 64) { const int k = i >> 7; const float gg = gq[k]; const f32x4 a = *(const f32x4*)(wq + (size_t)i * 8) * gg, b = *(const f32x4*)(wq + (size_t)i * 8 + 4) * gg; *(u32x4*)(WQ2 + (size_t)i * 8) = pack8(a, b); }
            }
            tr_job(args.in[13] + (size_t)l * DM * 2048, 2048, DM, 0, 2048, 2048, args.in[11] + l * DM, WKVT, DM, 2048 * l, 0, scr, lane, gw, NGW);
            tr_job(args.in[14] + (size_t)l * DM * DM, DM, DM, 0, DM, DM, nullptr, (bf16_t*)(wl + WO_WXOT), DM, 0, 0, scr, lane, gw, NGW);
            {
                const float* wg = args.in[16] + (size_t)l * DM * DFF; const float* wu = args.in[17] + (size_t)l * DM * DFF; const float* fg = args.in[15] + l * DM;
                bf16_t* WGUT = (bf16_t*)(wl + WO_WGUT);
                for (int it = gw; it < 16 * 88; it += NGW) { const int kb = it / 88, d = it % 88, j = d >> 2, s = (d >> 1) & 1, i = d & 1;
                    tr_item(s ? wu : wg, DFF, 128 * j + 64 * i, 64, fg, WGUT, DM, 64 * d, 0, 64 * kb, scr, lane); }
            }
            tr_job(args.in[18] + (size_t)l * DFF * DM, DM, DFF, 0, DM, DM, nullptr, (bf16_t*)(wl + WO_WDT), DFF, 0, 0, scr, lane, gw, NGW);
        }
        for (int m = gw; m < TOK; m += 4 * NGW) rows_to_bf16<4>(x_in, Xb, part, m, NGW, lane);
        for (int m = gw; m < NB * MEMLEN; m += NGW) rows_to_bf16<1>(mem_in, memb, partM, m, 0, lane);
    }
    PH_END(0);
    for (int l = 0; l < DEPTH; ++l) {
        unsigned char* wl = dsc + DO_W + (size_t)l * W_LAYER;
        for (int ch = 0; ch < NCH; ++ch) {
            const int r0 = ch * TC;
            bf16_t* proj = BIG;
            PH_BEGIN(2)
                pg8::Gemm g{Xb + (size_t)r0 * DM, (const bf16_t*)(wl + WO_W1T), DM, DM, DM, 0, 0}; pg8::StaticOrder<1> S; S.init(TC, W1_ROWS, G, bx);
                prep_rstd(lds, part + (size_t)r0 * 16, S);
                EpiInProj E{proj, logf, (const LAS float*)(lds + RSTD_TAB_OFF), args.in[4] + l * 8};
                pg8::gemm_phase<EpiInProj, 1>(lds, g, S, E);
            }
            PH_END(2);
            PH_BEGIN(3)
                int tidp = threadIdx.x; asm volatile("" : "+v"(tidp));
                const int lanep = tidp & 63, wavep = __builtin_amdgcn_readfirstlane(tidp >> 6);
                if (l == 0 && ch == 0 && G >= 128 && bx >= G - 64) {
                    pg8::Gemm g{memb, WKVT, DM, DM, DM, 0, 0}; pg8::StaticOrder<1> S; S.init(NB * MEMLEN, 4096, 64, bx - (G - 64));
                    prep_rstd(lds, partM, S);
                    EpiScale E{KVm, 4096, (const LAS float*)(lds + RSTD_TAB_OFF), 1.0f};
                    pg8::gemm_phase<EpiScale, 1>(lds, g, S, E);
                    __syncthreads();
                }
                for (int sb = bx; sb < BPC * 8; sb += G) {
                    const int bl = sb >> 3, h = sb & 7;
                    const float* lf = logf + (size_t)(bl * SEQ + 16 * tidp) * 8 + h;
                    float v[16]; float run = 0.f;
#pragma unroll
                    for (int i = 0; i < 16; ++i) { run += lf[i * 8]; v[i] = run; }
                    float xs = run;
#pragma unroll
                    for (int d = 1; d < 64; d <<= 1) { const float y = __shfl_up(xs, d); if (lanep >= d) xs += y; }
                    LAS float* wsum = (LAS float*)lds;
                    __syncthreads();
                    if (lanep == 63) wsum[wavep] = xs;
                    __syncthreads();
                    float off = xs - run;
                    for (int w = 0; w < wavep; ++w) off += wsum[w];
                    u32x4* co = (u32x4*)(ws + WS_KX) + (size_t)sb * SEQ + 16 * tidp;
#pragma unroll
                    for (int i = 0; i < 16; ++i) {
                        const float nv = -(off + v[i]) * LOG2E;
                        const unsigned a = cvt_pk_bf16(nv, 0.f) & 0xffffu; const float r1 = nv - __uint_as_float(a << 16);
                        const unsigned b = cvt_pk_bf16(r1, 0.f) & 0xffffu; const float r2 = r1 - __uint_as_float(b << 16);
                        const unsigned c = cvt_pk_bf16(r2, 0.f) & 0xffffu;
                        co[i] = (u32x4){a | (b << 16), c | 0x3f800000u, 0x3f803f80u, 0u};
                    }
                    __syncthreads();
                }
                {
                    const float* cw = args.in[5] + (size_t)l * 3 * 512;
                    const int nsb = (G > 2 * BPC * 8) ? BPC * 8 : 0;
                    for (int item = (bx - nsb) * 512 + tidp; bx >= nsb && item < (TC / 8) * 64; item += (G - nsb) * 512) {
                        const int cgp = item & 63, t0 = (item >> 6) * 8, c0 = cgp * 8;
                        float w0[8], w1[8], w2[8], z1[8], z2[8];
#pragma unroll
                        for (int j = 0; j < 8; ++j) { w0[j] = cw[c0 + j]; w1[j] = cw[512 + c0 + j]; w2[j] = cw[1024 + c0 + j]; z1[j] = 0.f; z2[j] = 0.f; }
                        if ((t0 % SEQ) != 0) {
                            const bf16_t* p2 = proj + (size_t)(t0 - 2) * PROJ_LD + c0; const bf16_t* p1 = proj + (size_t)(t0 - 1) * PROJ_LD + c0;
                            const u32x4 c2 = *(const u32x4*)(p2 + PC_C), u2 = *(const u32x4*)(p2 + PC_U), c1 = *(const u32x4*)(p1 + PC_C), u1 = *(const u32x4*)(p1 + PC_U);
#pragma unroll
                            for (int j = 0; j < 4; ++j) { z2[2 * j] = bf_lo(c2[j]) * bf_lo(u2[j]); z2[2 * j + 1] = bf_hi(c2[j]) * bf_hi(u2[j]); z1[2 * j] = bf_lo(c1[j]) * bf_lo(u1[j]); z1[2 * j + 1] = bf_hi(c1[j]) * bf_hi(u1[j]); }
                        }
                        u32x4 yo[8];
#pragma unroll
                        for (int i = 0; i < 8; ++i) {
                            bf16_t* p = proj + (size_t)(t0 + i) * PROJ_LD + c0;
                            const u32x4 cc = *(const u32x4*)(p + PC_C), uu = *(const u32x4*)(p + PC_U), bb = *(const u32x4*)(p + PC_B);
                            float z0[8], y[8];
#pragma unroll
                            for (int j = 0; j < 4; ++j) { z0[2 * j] = bf_lo(cc[j]) * bf_lo(uu[j]); z0[2 * j + 1] = bf_hi(cc[j]) * bf_hi(uu[j]); }
#pragma unroll
                            for (int j = 0; j < 4; ++j) { y[2 * j] = bf_lo(bb[j]) * (w0[2 * j] * z2[2 * j] + w1[2 * j] * z1[2 * j] + w2[2 * j] * z0[2 * j]);
                                y[2 * j + 1] = bf_hi(bb[j]) * (w0[2 * j + 1] * z2[2 * j + 1] + w1[2 * j + 1] * z1[2 * j + 1] + w2[2 * j + 1] * z0[2 * j + 1]); }
                            u32x4 o; o.x = cvt_pk_bf16(y[0], y[1]); o.y = cvt_pk_bf16(y[2], y[3]); o.z = cvt_pk_bf16(y[4], y[5]); o.w = cvt_pk_bf16(y[6], y[7]);
                            yo[i] = o;
#pragma unroll
                            for (int j = 0; j < 8; ++j) { z2[j] = z1[j]; z1[j] = z0[j]; }
                        }
#pragma unroll
                        for (int i = 0; i < 8; ++i) *(u32x4*)(proj + (size_t)(t0 + i) * PROJ_LD + c0 + PC_B) = yo[i];
                    }
                }
                {
                    int t4 = threadIdx.x; asm volatile("" : "+v"(t4));
                    const int ln = t4 & 63, hd = ln >> 3, sub = ln & 7;
                    unsigned* tq = (unsigned*)(ws + 32768) + (l * NCH + ch) * 1088;
                    for (int rb = vcu * 8 + (t4 >> 6); rb < TC / 16; rb += NGW) {
                        float mq = 0.f, mk = 0.f, md = -INFINITY;
#pragma unroll 4
                        for (int i = 0; i < 16; ++i) {
                            const bf16_t* p = proj + (size_t)(rb * 16 + i) * PROJ_LD + hd * 64 + sub * 8;
                            const u32x4 qv = *(const u32x4*)(p + PC_FQ), kv = *(const u32x4*)(p + PC_FK);
                            float qq = 0.f, kk = 0.f, qk = 0.f;
#pragma unroll
                            for (int j = 0; j < 4; ++j) { const float q0 = bf_lo(qv[j]), q1 = bf_hi(qv[j]), k0 = bf_lo(kv[j]), k1 = bf_hi(kv[j]); qq += q0 * q0 + q1 * q1; kk += k0 * k0 + k1 * k1; qk += q0 * k0 + q1 * k1; }
#pragma unroll
                            for (int o = 1; o < 8; o <<= 1) { qq += __shfl_xor(qq, o); kk += __shfl_xor(kk, o); qk += __shfl_xor(qk, o); }
                            mq = fmaxf(mq, qq); mk = fmaxf(mk, kk); md = fmaxf(md, -qk);
                        }
                        if (sub == 0) {
                            const int row0 = rb * 16, bh = (row0 / SEQ) * 8 + hd, qb = (row0 % SEQ) >> 8;
                            const unsigned db = __float_as_uint(md), dkey = (db & 0x80000000u) ? ~db : (db | 0x80000000u);
                            atomicMax(tq + bh, __float_as_uint(mq)); atomicMax(tq + 32 + bh, __float_as_uint(mk)); atomicMax(tq + 64 + bh * 32 + qb, dkey);
                        }
                    }
                }
                __syncthreads();
                {
                    LAS float* bt8 = (LAS float*)(lds + 6 * (64 * 144 + 64 * 160));
                    int t3 = threadIdx.x; asm volatile("" : "+v"(t3));
                    for (int idx = t3; idx < 1024; idx += 512) bt8[idx] = args.in[9][(int)T5_BUCKET[idx & 127] * 8 + (idx >> 7)] * LOG2E;
                }
                __syncthreads();
                for (int un = vcu; un < BPC * 8 * 32; un += G) {
                    const int qb = un & 31, hq = (un >> 5) & 7, bl = un >> 8, kvh = hq >> 2;
                    const bf16_t* base = proj + (size_t)bl * SEQ * PROJ_LD;
                    const int q0 = qb * 256; const int tl = q0 >= 128 ? (q0 - 128) / 64 : 0;
                    attn_unit<64, 2, 1, 6>(lds, base + (size_t)q0 * PROJ_LD + PC_SQ + hq * 64, PROJ_LD, base + PC_SK + kvh * 64, PROJ_LD, base + PC_SV + kvh * 64, PROJ_LD,
                                        proj + ((size_t)bl * SEQ + q0) * PROJ_LD + PC_SQ + hq * 64, PROJ_LD, q0, tl, (q0 + 256) / 64, hq, args.in[6][l * 8 + hq] * LOG2E);
                }
            }
            PH_END(3);
            PH_BEGIN(4)
                int tidq = threadIdx.x; asm volatile("" : "+v"(tidq));
                const int waveq = __builtin_amdgcn_readfirstlane(tidq >> 6);
                if (l == 0 && ch == 0) {
                    {   int ci = bx >> 4; asm volatile("" : "+s"(ci));
                        const int fl = ci >> 3, ty = (ci >> 2) & 1, fh = ci & 3;
                        unsigned char* wlf = dsc + DO_W + (size_t)fl * W_LAYER;
                        const bf16_t* kvl = KVm + fl * 2048 + fh * 256;
                        pg8::StaticOrder<1> S; S.init(NB * MEMLEN, DM, 16, bx & 15);
                        bf16_t* fo = (bf16_t*)(dsc + (ty == 0 ? (fl == 0 ? DO_QKF0 : DO_QKF1) : (fl == 0 ? DO_VWF0 : DO_VWF1)));
                        if (ty == 0) {
                            pg8::Gemm g{kvl, (const bf16_t*)(wlf + WO_WXQT) + fh * 256, 4096, DM, 256, 0, 0};
                            EpiFold E{fo, DM * DM, 256, fh * 256 * DM, C2_256};
                            pg8::gemm_phase<EpiFold, 1>(lds, g, S, E);
                        } else {
                            pg8::Gemm g{(const bf16_t*)(wlf + WO_WXOT) + fh * 256, kvl + 1024, DM, 4096, 256, 0, 0};
                            EpiFold E{fo, 256 * DM, DM * DM, fh * 256, 1.0f};
                            pg8::gemm_phase<EpiFold, 1>(lds, g, S, E);
                        }
                        __syncthreads();
                    }
                }
                const int inst = l * NCH + ch, nbh = BPC * 8, nun = nbh * 32;
                unsigned* qctr = (unsigned*)(ws + 20480) + 64 * inst;
                const unsigned* tq = (const unsigned*)(ws + 32768) + inst * 1088;
                volatile LAS int* sh = (volatile LAS int*)(lds + 146944);
                for (;;) {
                    __syncthreads();
                    if (waveq == 0) {
                        int lane = threadIdx.x & 63; asm volatile("" : "+v"(lane));
                        int u = 0; if (lane == 0) u = (int)atomicAdd(qctr, 1u);
                        u = __builtin_amdgcn_readfirstlane(u);
                        int t0 = 0;
                        if (u < nun) {
                            const int qb = 31 - u / nbh, bh = u % nbh, NT = 4 * qb + 4;
                            const u32x4* kx = (const u32x4*)(ws + WS_KX) + (size_t)bh * SEQ;
                            const float qk = sqrtf(__uint_as_float(tq[bh]) * __uint_as_float(tq[32 + bh])) * 1.0001f;
                            const unsigned dkey = tq[64 + bh * 32 + qb]; const float dmin = -__uint_as_float((dkey & 0x80000000u) ? (dkey & 0x7fffffffu) : ~dkey);
                            const u32x4 w0 = kx[qb * 256]; const float nk0 = bf_lo(w0.x) + bf_hi(w0.x) + bf_lo(w0.y);
                            const bool valid = (2 * lane + 2 <= NT - 4);
                            float nkp = 0.f; if (valid) { const u32x4 w = kx[128 * lane + 127]; nkp = bf_lo(w.x) + bf_hi(w.x) + bf_lo(w.y); }
                            const bool skip = valid && (nkp - nk0 + qk - dmin <= -32.0f);
                            const unsigned long long mk = __ballot(skip);
                            const int np = (~mk == 0ull) ? 64 : (__ffsll((long long)~mk) - 1);
                            t0 = 2 * np;
                        }
                        if (lane == 0) { sh[0] = u; sh[1] = t0; }
                    }
                    __syncthreads();
                    const int u = sh[0], t0 = sh[1];
                    if (u >= nun) break;
                    const int qb = 31 - u / nbh, bh = u % nbh;
                    fox::attn_unit<32>(bh >> 3, bh & 7, qb, (const fox::bf16*)(proj + PC_FQ), (const fox::bf16*)(proj + PC_FK), (const fox::bf16*)(proj + PC_FV),
                                      (const fox::bf16*)(ws + WS_KX) + (size_t)bh * SEQ * 8, (fox::bf16*)(proj + PC_FQ), (char*)lds_raw, t0);
                }
            }
            PH_END(4);
            PH_BEGIN(5)
                pg8::Gemm g{proj, (const bf16_t*)(wl + WO_WBT), PROJ_LD, 1536, 512, 1536, 512}; pg8::StaticOrder<3> S; S.init(TC, DM, G, bx);
                EpiMerge E{proj, NCH == 1 ? proj + PC_G : (bf16_t*)(ws + WS_MERGED2) + (size_t)r0 * DM, NCH == 1 ? PROJ_LD : DM};
                pg8::gemm_phase<EpiMerge, 3>(lds, g, S, E);
            }
            PH_END(5);
        }
        PH_BEGIN(6)
            pg8::Gemm g{NCH == 1 ? BIG + PC_G : (const bf16_t*)(ws + WS_MERGED2), (const bf16_t*)(wl + WO_WOT), NCH == 1 ? PROJ_LD : DM, DM, DM, 0, 0}; pg8::StaticOrder<1> S; S.init(TOK, DM, G, bx);
            EpiResid E{l == 0 ? x_in : nullptr, Xb, part};
            pg8::gemm_phase<EpiResid, 1>(lds, g, S, E);
        }
        PH_END(6);
        bf16_t* Qx = BIG;
        const bf16_t* QKF = (const bf16_t*)(dsc + (l == 0 ? DO_QKF0 : DO_QKF1)); const bf16_t* VWF = (const bf16_t*)(dsc + (l == 0 ? DO_VWF0 : DO_VWF1));
        PH_BEGIN(7)
            pg8::Gemm g{Xb, QKF, DM, DM, DM, 0, 0}; g.bsB = DM * DM; g.ppb = SEQ / 256; pg8::StaticOrder<1> S; S.init(TOK, DM, G, bx);
            prep_rstd(lds, part, S);
            EpiSoftmax E{Qx, (const LAS float*)(lds + RSTD_TAB_OFF), (LAS float*)(lds + RSTD_TAB_OFF + 4096)};
            pg8::gemm_phase<EpiSoftmax, 1>(lds, g, S, E);
        }
        PH_END(7);
        PH_BEGIN(9)
            pg8::Gemm g{Qx, VWF, DM, DM, DM, 0, 0}; g.bsB = DM * DM; g.ppb = SEQ / 256; pg8::StaticOrder<1> S; S.init(TOK, DM, G, bx);
            EpiResid E{nullptr, Xb, part};
            pg8::gemm_phase<EpiResid, 1>(lds, g, S, E);
        }
        PH_END(9);
        bf16_t* Hb = BIG;
        PH_BEGIN(10)
            pg8::Gemm g{Xb, (const bf16_t*)(wl + WO_WGUT), DM, DM, DM, 0, 0}; pg8::StaticOrder<1> S; S.init(TOK, 2 * DFF, G, bx);
            prep_rstd(lds, part, S);
            EpiSwiglu E{Hb, (const LAS float*)(lds + RSTD_TAB_OFF)};
            pg8::gemm_phase<EpiSwiglu, 1>(lds, g, S, E);
        }
        PH_END(10);
        PH_BEGIN(11)
            pg8::Gemm g{Hb, (const bf16_t*)(wl + WO_WDT), DFF, DFF, DFF, 0, 0}; pg8::StaticOrder<1> S; S.init(TOK, DM, G, bx);
            EpiResid E{nullptr, Xb, part};
            pg8::gemm_phase<EpiResid, 1>(lds, g, S, E);
        }
        PH_END(11);
    }
    PH_BEGIN(12)
        const float* fg = args.in[19];
        int t2 = threadIdx.x; asm volatile("" : "+v"(t2));
        const int lane = t2 & 63, gw = vcu * 8 + (t2 >> 6);
        for (int m0 = gw; m0 < TOK; m0 += 4 * NGW) {
            u32x2 w[4][4];
#pragma unroll
            for (int r = 0; r < 4; ++r) { const u32x2* xr = (const u32x2*)(Xb + (size_t)(m0 + r * NGW) * DM) + lane;
#pragma unroll
                for (int j = 0; j < 4; ++j) w[r][j] = xr[64 * j]; }
#pragma unroll
            for (int r = 0; r < 4; ++r) {
                f32x4* orow = (f32x4*)(X + (size_t)(m0 + r * NGW) * DM) + lane; f32x4 v[4]; float s = 0.f;
#pragma unroll
                for (int j = 0; j < 4; ++j) { v[j] = (f32x4){bf_lo(w[r][j].x), bf_hi(w[r][j].x), bf_lo(w[r][j].y), bf_hi(w[r][j].y)}; s += (v[j][0] * v[j][0] + v[j][1] * v[j][1]) + (v[j][2] * v[j][2] + v[j][3] * v[j][3]); }
                const float rstd = 1.0f / sqrtf(wave_sum(s) * (1.0f / DM) + RMS_EPS);
#pragma unroll
                for (int j = 0; j < 4; ++j) { const f32x4 gg = *((const f32x4*)fg + lane + 64 * j); orow[64 * j] = v[j] * rstd * gg; }
            }
        }
    }
    PH_END(12);
#undef PH_ON
#undef PH_END
#undef PH_BEGIN
}

extern "C" void kernel_launch(void* const* d_in, const int* in_sizes, int n_in, void* d_out, int out_size, void* d_ws, size_t ws_size, hipStream_t stream) {
    static int grid = 0;
    if (grid == 0) {
        int dev = 0, cus = 0;
        if (n_in != 20 || out_size != TOK * DM || ws_size < WS_NEED2) { fprintf(stderr, "kernel_launch: unexpected problem (n_in %d out %d ws %zu)\n", n_in, out_size, ws_size); grid = -1; return; }
        hipGetDevice(&dev); hipDeviceGetAttribute(&cus, hipDeviceAttributeMultiprocessorCount, dev);
        if (hipFuncSetAttribute((const void*)mk_fwd, hipFuncAttributeMaxDynamicSharedMemorySize, LDS_BYTES) != hipSuccess) { fprintf(stderr, "kernel_launch: hipFuncSetAttribute failed\n"); grid = -1; return; }
        int per_cu = 0;
        hipOccupancyMaxActiveBlocksPerMultiprocessor(&per_cu, (const void*)mk_fwd, 512, LDS_BYTES);
        (void)hipGetLastError();
        fprintf(stderr, "kernel_launch: cus %d per_cu %d ws %zu\n", cus, per_cu, ws_size);
        if (cus != 256) { fprintf(stderr, "kernel_launch: built for a 256-CU device (got %d)\n", cus); grid = -1; return; }
        grid = cus;
    }
    if (grid < 0) return;
    if (hipMemsetAsync(d_ws, 0, 32768, stream) != hipSuccess) { fprintf(stderr, "kernel_launch: memset failed\n"); return; }
    Args a{};
    for (int i = 0; i < 20; ++i) a.in[i] = (const float*)d_in[i];
    a.out = (float*)d_out; a.ws = (unsigned char*)d_ws; a.nch = (ws_size >= WS_NEED1) ? 1 : 2; a.pad = 0;
    const int nph = 1 + DEPTH * (a.nch * 4 + 5) + 1;
#if MK_SINGLE
    a.ph_lo = 0; a.ph_hi = nph;
    void* kargs[] = {&a};
    hipError_t e = hipLaunchCooperativeKernel((const void*)mk_fwd, dim3(grid), dim3(512), kargs, LDS_BYTES, stream);
    if (e != hipSuccess) fprintf(stderr, "cooperative launch failed: %s\n", hipGetErrorString(e));
#else
    for (int p = 0; p < nph; ++p) { a.ph_lo = p; a.ph_hi = p + 1; hipLaunchKernelGGL(mk_fwd, dim3(grid), dim3(512), LDS_BYTES, stream, a); }
#endif
}
```
